# Optimizing an MI355X kernel written in HIP

```python
import math
import jax, jax.numpy as jnp
from jax import lax
import numpy as np

D_MODEL = 1024
BATCH = 2
SEQ = 8192
DEPTH = 1

CHUNK = 64
N_META = 16
ATT_HEADS = 8
HEAD_DIM = 64
ATT_WIDTH = ATT_HEADS * HEAD_DIM
Q_BLOCK = 128
SSM_WIDTH = D_MODEL // 2
SSM_GROUP = 16
SSM_GROUPS = SSM_WIDTH // SSM_GROUP
SSM_STATE = 64
N_EXPERTS = 32
TOP_K = 4
D_EXPERT = D_MODEL
SWIGLU_LIMIT = 7.0
SWIGLU_ALPHA = 1.702
LN_EPS = 1e-5
DEEPNORM_ALPHA = (2.0 * DEPTH) ** 0.25
DEEPNORM_BETA = (8.0 * DEPTH) ** -0.25

Q_OFF = 0
K_OFF = Q_OFF + ATT_WIDTH
V_OFF = K_OFF + ATT_WIDTH
F_OFF = V_OFF + ATT_WIDTH
U_OFF = F_OFF + ATT_HEADS
GA_OFF = U_OFF + SSM_WIDTH
GB_OFF = GA_OFF + D_MODEL
IN_COLS = GB_OFF + D_MODEL

kernel_name = "hybrid_fox_s5_moe_deepnorm"


def layer_norm(x, g, b):
    xf = x.astype(jnp.float32)
    mu = jnp.mean(xf, axis=-1, keepdims=True)
    var = jnp.mean(jnp.square(xf - mu), axis=-1, keepdims=True)
    return ((xf - mu) * lax.rsqrt(var + LN_EPS) * g + b).astype(x.dtype)


def forgetting_attention(q, k, v, log_f):
    bsz, length, n_h, dh = q.shape
    n_blk = -(-length // Q_BLOCK)
    pad = n_blk * Q_BLOCK - length
    to_bhld = lambda a: jnp.pad(a.transpose(0, 2, 1, 3), ((0, 0), (0, 0), (0, pad), (0, 0)))
    q, k, v = to_bhld(q), to_bhld(k), to_bhld(v)
    cum_f = jnp.cumsum(log_f, axis=1).transpose(0, 2, 1)
    cum_f = jnp.pad(cum_f, ((0, 0), (0, 0), (0, pad)))
    k_pos = jnp.arange(n_blk * Q_BLOCK)
    scale = 1.0 / math.sqrt(dh)

    def one_block(i):
        start = i * Q_BLOCK
        q_blk = lax.dynamic_slice_in_dim(q, start, Q_BLOCK, axis=2)
        f_q = lax.dynamic_slice_in_dim(cum_f, start, Q_BLOCK, axis=2)
        s = jnp.einsum('bhqd,bhkd->bhqk', q_blk, k).astype(jnp.float32) * scale
        s = s + f_q[..., None] - cum_f[:, :, None, :]
        q_pos = start + jnp.arange(Q_BLOCK)
        s = jnp.where(k_pos[None, :] <= q_pos[:, None], s, -jnp.inf)
        p = jax.nn.softmax(s, axis=-1).astype(v.dtype)
        return jnp.einsum('bhqk,bhkd->bhqd', p, v)

    out = lax.map(one_block, jnp.arange(n_blk))
    out = out.transpose(1, 0, 3, 2, 4).reshape(bsz, n_blk * Q_BLOCK, n_h * dh)
    return out[:, :length]


def s5_ssm(u, a_re, a_im, log_dt, b_re, b_im, c_re, c_im, d_skip):
    bsz, length, n_g, n_c = u.shape
    f32 = jnp.float32
    a_re = a_re.astype(f32); a_im = a_im.astype(f32)
    dt = jnp.exp(log_dt.astype(f32))[:, None]
    mag = jnp.exp(a_re * dt)
    ang = a_im * dt
    lb_re, lb_im = mag * jnp.cos(ang), mag * jnp.sin(ang)
    den = a_re * a_re + a_im * a_im
    z_re, z_im = lb_re - 1.0, lb_im
    coef_re = (z_re * a_re + z_im * a_im) / den
    coef_im = (z_im * a_re - z_re * a_im) / den
    b_re = b_re.astype(f32); b_im = b_im.astype(f32)
    bb_re = coef_re[..., None] * b_re - coef_im[..., None] * b_im
    bb_im = coef_re[..., None] * b_im + coef_im[..., None] * b_re
    uf = u.astype(f32)
    bu_re = jnp.einsum('blgc,gpc->lbgp', uf, bb_re)
    bu_im = jnp.einsum('blgc,gpc->lbgp', uf, bb_im)
    a_r = jnp.broadcast_to(lb_re, (length, 1, n_g, lb_re.shape[-1]))
    a_i = jnp.broadcast_to(lb_im, (length, 1, n_g, lb_im.shape[-1]))

    def combine(e1, e2):
        ar1, ai1, br1, bi1 = e1
        ar2, ai2, br2, bi2 = e2
        return (ar1 * ar2 - ai1 * ai2,
                ar1 * ai2 + ai1 * ar2,
                ar2 * br1 - ai2 * bi1 + br2,
                ar2 * bi1 + ai2 * br1 + bi2)

    _, _, x_re, x_im = lax.associative_scan(combine, (a_r, a_i, bu_re, bu_im), axis=0)
    y = (jnp.einsum('lbgp,gcp->blgc', x_re, c_re.astype(f32))
         - jnp.einsum('lbgp,gcp->blgc', x_im, c_im.astype(f32))
         + d_skip.astype(f32) * uf)
    return y.reshape(bsz, length, n_g * n_c)


def hybrid_mixer(h, w_in, b_f, w_up_a, w_up_b, w_o, a_re, a_im, log_dt, b_re, b_im,
                 c_re, c_im, d_skip, w_glu, b_glu):
    bsz, length, _ = h.shape
    proj = h @ w_in
    q = proj[..., Q_OFF:K_OFF].reshape(bsz, length, ATT_HEADS, HEAD_DIM)
    k = proj[..., K_OFF:V_OFF].reshape(bsz, length, ATT_HEADS, HEAD_DIM)
    v = proj[..., V_OFF:F_OFF].reshape(bsz, length, ATT_HEADS, HEAD_DIM)
    log_f = jax.nn.log_sigmoid((proj[..., F_OFF:U_OFF] + b_f).astype(jnp.float32))
    y_a = forgetting_attention(q, k, v, log_f)

    u = proj[..., U_OFF:GA_OFF].reshape(bsz, length, SSM_GROUPS, SSM_GROUP)
    y_b = jax.nn.gelu(s5_ssm(u, a_re, a_im, log_dt, b_re, b_im, c_re, c_im, d_skip)).astype(h.dtype)
    y_b = y_b * jax.nn.sigmoid(y_b @ w_glu + b_glu)

    g_a = jax.nn.sigmoid(proj[..., GA_OFF:GB_OFF])
    g_b = jax.nn.sigmoid(proj[..., GB_OFF:IN_COLS])
    merged = g_a * (y_a @ w_up_a) + g_b * (y_b @ w_up_b)
    return merged @ w_o


def moe_ffn(h, w_router, b_router, w_gate, b_gate, w_up, b_up, w_down, b_down):
    bsz, length, dm = h.shape
    t = h.reshape(-1, dm)
    logits = (t @ w_router + b_router).astype(jnp.float32)
    top_v, top_i = lax.top_k(logits, TOP_K)
    top_w = jax.nn.softmax(top_v, axis=-1)
    comb = jnp.einsum('tk,tke->te', top_w, jax.nn.one_hot(top_i, N_EXPERTS, dtype=jnp.float32))
    out = jnp.zeros(t.shape, jnp.float32)
    for e in range(N_EXPERTS):
        gate = jnp.minimum(t @ w_gate[e] + b_gate[e], SWIGLU_LIMIT)
        up = jnp.clip(t @ w_up[e] + b_up[e], -SWIGLU_LIMIT, SWIGLU_LIMIT)
        act = (up + 1.0) * gate * jax.nn.sigmoid(SWIGLU_ALPHA * gate)
        out = out + comb[:, e:e + 1] * (act @ w_down[e] + b_down[e])
    return out.reshape(bsz, length, dm).astype(h.dtype)


def setup_inputs(seed: int = 0) -> dict:
    key = jax.random.key(seed)
    ks = iter(jax.random.split(key, 40))
    nrm = lambda shape, s: jax.random.normal(next(ks), shape, jnp.float32) * s
    dm, L_ = D_MODEL, DEPTH
    x = nrm((BATCH, SEQ, dm), 1.0)
    meta = nrm((N_META, dm), 1.0)
    ln_in_g = 1.0 + nrm((dm,), 0.02)
    ln_in_b = nrm((dm,), 0.02)
    w_in = nrm((L_, dm, IN_COLS), dm ** -0.5)
    w_in = w_in.at[:, :, V_OFF:F_OFF].multiply(DEEPNORM_BETA)
    b_f = jax.random.uniform(next(ks), (L_, ATT_HEADS), jnp.float32, 1.0, 4.0)
    w_up_a = nrm((L_, ATT_WIDTH, dm), DEEPNORM_BETA * ATT_WIDTH ** -0.5)
    w_up_b = nrm((L_, SSM_WIDTH, dm), DEEPNORM_BETA * SSM_WIDTH ** -0.5)
    w_o = nrm((L_, dm, dm), DEEPNORM_BETA * dm ** -0.5)
    ssm_a_re = -0.5 + nrm((L_, SSM_GROUPS, SSM_STATE), 0.01)
    ssm_a_im = jnp.pi * jnp.arange(SSM_STATE, dtype=jnp.float32) + nrm((L_, SSM_GROUPS, SSM_STATE), 0.01)
    ssm_log_dt = jax.random.uniform(next(ks), (L_, SSM_GROUPS), jnp.float32,
                                    math.log(0.001), math.log(0.1))
    ssm_b_re = nrm((L_, SSM_GROUPS, SSM_STATE, SSM_GROUP), (2 * SSM_GROUP) ** -0.5)
    ssm_b_im = nrm((L_, SSM_GROUPS, SSM_STATE, SSM_GROUP), (2 * SSM_GROUP) ** -0.5)
    ssm_c_re = nrm((L_, SSM_GROUPS, SSM_GROUP, SSM_STATE), (2 * SSM_STATE) ** -0.5)
    ssm_c_im = nrm((L_, SSM_GROUPS, SSM_GROUP, SSM_STATE), (2 * SSM_STATE) ** -0.5)
    ssm_d = nrm((L_, SSM_GROUPS, SSM_GROUP), 1.0)
    w_glu = nrm((L_, SSM_WIDTH, SSM_WIDTH), SSM_WIDTH ** -0.5)
    b_glu = nrm((L_, SSM_WIDTH), 0.02)
    ln1_g = 1.0 + nrm((L_, dm), 0.02)
    ln1_b = nrm((L_, dm), 0.02)
    w_router = nrm((L_, dm, N_EXPERTS), dm ** -0.5)
    b_router = nrm((L_, N_EXPERTS), 0.01)
    w_gate = nrm((L_, N_EXPERTS, dm, D_EXPERT), dm ** -0.5)
    b_gate = nrm((L_, N_EXPERTS, D_EXPERT), 0.02)
    w_up = nrm((L_, N_EXPERTS, dm, D_EXPERT), dm ** -0.5)
    b_up = nrm((L_, N_EXPERTS, D_EXPERT), 0.02)
    w_down = nrm((L_, N_EXPERTS, D_EXPERT, dm), DEEPNORM_BETA * D_EXPERT ** -0.5)
    b_down = nrm((L_, N_EXPERTS, dm), 0.02)
    ln2_g = 1.0 + nrm((L_, dm), 0.02)
    ln2_b = nrm((L_, dm), 0.02)
    return {"x": x, "meta": meta, "ln_in_g": ln_in_g, "ln_in_b": ln_in_b,
            "w_in": w_in, "b_f": b_f, "w_up_a": w_up_a, "w_up_b": w_up_b, "w_o": w_o,
            "ssm_a_re": ssm_a_re, "ssm_a_im": ssm_a_im, "ssm_log_dt": ssm_log_dt,
            "ssm_b_re": ssm_b_re, "ssm_b_im": ssm_b_im, "ssm_c_re": ssm_c_re, "ssm_c_im": ssm_c_im,
            "ssm_d": ssm_d, "w_glu": w_glu, "b_glu": b_glu, "ln1_g": ln1_g, "ln1_b": ln1_b,
            "w_router": w_router, "b_router": b_router, "w_gate": w_gate, "b_gate": b_gate,
            "w_up": w_up, "b_up": b_up, "w_down": w_down, "b_down": b_down,
            "ln2_g": ln2_g, "ln2_b": ln2_b}


def reference(x, meta, ln_in_g, ln_in_b, w_in, b_f, w_up_a, w_up_b, w_o,
              ssm_a_re, ssm_a_im, ssm_log_dt, ssm_b_re, ssm_b_im, ssm_c_re, ssm_c_im,
              ssm_d, w_glu, b_glu, ln1_g, ln1_b, w_router, b_router, w_gate, b_gate,
              w_up, b_up, w_down, b_down, ln2_g, ln2_b):
    bsz = x.shape[0]
    meta_b = jnp.broadcast_to(meta[None].astype(x.dtype), (bsz, N_META, D_MODEL))
    h = jnp.concatenate([meta_b, x], axis=1)
    h = layer_norm(h, ln_in_g, ln_in_b)
    for l in range(DEPTH):
        mix = hybrid_mixer(h, w_in[l], b_f[l], w_up_a[l], w_up_b[l], w_o[l],
                           ssm_a_re[l], ssm_a_im[l], ssm_log_dt[l], ssm_b_re[l], ssm_b_im[l],
                           ssm_c_re[l], ssm_c_im[l], ssm_d[l], w_glu[l], b_glu[l])
        h = layer_norm(DEEPNORM_ALPHA * h + mix, ln1_g[l], ln1_b[l])
        ffn = moe_ffn(h, w_router[l], b_router[l], w_gate[l], b_gate[l],
                      w_up[l], b_up[l], w_down[l], b_down[l])
        h = layer_norm(DEEPNORM_ALPHA * h + ffn, ln2_g[l], ln2_b[l])
    return h[:, N_META:]
```

```cpp
#include <hip/hip_runtime.h>
#include <cstdio>
#include <cstdint>

#define LAS __attribute__((address_space(3)))
#define GAS __attribute__((address_space(1)))
typedef unsigned short bf16;
typedef short bf16x8 __attribute__((ext_vector_type(8)));
typedef float f32x4 __attribute__((ext_vector_type(4)));
typedef float f32x2 __attribute__((ext_vector_type(2)));
typedef unsigned u32x4 __attribute__((ext_vector_type(4)));
typedef unsigned u32x2 __attribute__((ext_vector_type(2)));
typedef GAS unsigned gu32;

constexpr int NB = 2, SEQ = 8192, M = NB * SEQ, D = 1024, NMETA = 16, NH = 8, HD = 64, AW = 512, SW = 512, NG = 32, GC = 16, NP = 64, NE = 32, TOPK = 4;
constexpr int IN_COLS = 4104, F_OFF = 1536, U_OFF = 1544, GA_OFF = 2056, GB_OFF = 3080;
constexpr float LN_EPS = 1e-5f;
constexpr float ALPHA = 1.189207115002721f;
constexpr float LOG2E = 1.4426950408889634f;
constexpr float QSCALE = 0.125f * LOG2E;
constexpr float SW_LIMIT = 7.0f, SW_ALPHA = 1.702f;
constexpr int LIST_CAP = M;
constexpr int ACT_ROWS = 73728;

constexpr size_t MiB = 1u << 20;
constexpr size_t WS_CTL = 0, CTL_ZERO_BYTES = 1 * MiB;
constexpr size_t WS_WIN = 2 * MiB;
constexpr size_t WS_WUPA = 10 * MiB, WS_WUPB = 11 * MiB, WS_WO = 12 * MiB, WS_WGLU = 14 * MiB;
constexpr size_t WS_SMALL = 15 * MiB;
constexpr size_t WS_LOGF = 16 * MiB;
constexpr size_t WS_F2X = 17 * MiB;
constexpr size_t WS_LIST = 18 * MiB;
constexpr size_t WS_WSLOT = 20 * MiB;
constexpr size_t WS_WGU = 32 * MiB;
constexpr size_t WS_YS = 32 * MiB;
constexpr size_t WS_WD = 160 * MiB;
constexpr size_t WS_XN = 224 * MiB;
constexpr size_t WS_ACT = 224 * MiB;
constexpr size_t WS_Q = 256 * MiB, WS_K = 272 * MiB, WS_V = 288 * MiB, WS_U = 304 * MiB;
constexpr size_t WS_MG = 256 * MiB;
constexpr size_t WS_GA = 320 * MiB, WS_GB = 352 * MiB;
constexpr size_t WS_YA = 384 * MiB, WS_YB = 400 * MiB, WS_YG = 416 * MiB, WS_T1 = 432 * MiB;
constexpr size_t WS_H1B = 368 * MiB;
constexpr size_t WS_MIX = 400 * MiB;
constexpr size_t WS_END = 464 * MiB;
constexpr size_t SM_KMETA = 0, SM_VMETA = 16384, SM_LOGFM = 32768, SM_UMETA = 36864, SM_F2M = 69632;
constexpr int CW_TMO = 0, CW_CODE = 1;
constexpr int CW_CNT = 64;
constexpr int CW_BAR = 4096;

constexpr int RING_BYTES = 131072;
constexpr int LDSCTL_OFF = RING_BYTES, MISC_OFF = LDSCTL_OFF + 320, TAB_OFF = LDSCTL_OFF + 1024;
constexpr int LDS_BYTES = 147456;
constexpr int NWAVES = 8;

#ifndef MK_N_LAUNCHES
#define MK_N_LAUNCHES 1
#endif
constexpr int NPHASES = 10;

#define RLX_AGENT __ATOMIC_RELAXED, __HIP_MEMORY_SCOPE_AGENT
#define LDS_WAIT() asm volatile("s_waitcnt lgkmcnt(0)" ::: "memory")
#define VM_WAIT() asm volatile("s_waitcnt vmcnt(0)" ::: "memory")
__device__ __forceinline__ unsigned f2bf(float f) { unsigned u = __builtin_bit_cast(unsigned, f); return (u + 0x7fffu + ((u >> 16) & 1u)) >> 16; }
__device__ __forceinline__ unsigned pk2(float lo, float hi) { return f2bf(lo) | (f2bf(hi) << 16); }
__device__ __forceinline__ unsigned cvt_pk_bf16(float lo, float hi) { unsigned r; asm volatile("v_cvt_pk_bf16_f32 %0, %1, %2" : "=v"(r) : "v"(lo), "v"(hi)); return r; }
__device__ __forceinline__ float bflo(unsigned u) { return __builtin_bit_cast(float, u << 16); }
__device__ __forceinline__ float bfhi(unsigned u) { return __builtin_bit_cast(float, u & 0xffff0000u); }
__device__ __forceinline__ float sigmoidf_(float x) { return __builtin_amdgcn_rcpf(1.0f + __builtin_amdgcn_exp2f(-x * LOG2E)); }
__device__ __forceinline__ int fresh_tid() { int t = threadIdx.x; asm volatile("" : "+v"(t)); return t; }
__device__ __forceinline__ float wave_sum(float v) {
#pragma unroll
    for (int o = 1; o < 64; o <<= 1) v += __shfl_xor(v, o);
    return v;
}
__device__ __forceinline__ float log_sigmoidf_(float x) { const float y = __expf(-fabsf(x)); return fminf(x, 0.f) - __logf(1.0f + y); }
__device__ __forceinline__ float gelu_tanh(float x) {
    const float z = 0.7978845608028654f * (x + 0.044715f * x * x * x);
    return x * sigmoidf_(2.0f * z);
}
__device__ __forceinline__ void sincos_acc(float x, float& s, float& c) {
    const float kf = rintf(x * 0.6366197723675814f); const int k = (int)kf;
    float r = fmaf(-kf, 1.5703125f, x); r = fmaf(-kf, 4.837512969970703125e-4f, r); r = fmaf(-kf, 7.54978995489188216e-8f, r);
    const float r2 = r * r;
    const float sp = r + r * r2 * (-1.6666654611e-1f + r2 * (8.3321608736e-3f + r2 * (-1.9515295891e-4f)));
    const float cp = 1.0f - 0.5f * r2 + r2 * r2 * (4.166664568298827e-2f + r2 * (-1.388731625493765e-3f + r2 * 2.443315711809948e-5f));
    const int q = k & 3;
    s = (q == 0) ? sp : (q == 1) ? cp : (q == 2) ? -sp : -cp;
    c = (q == 0) ? cp : (q == 1) ? -sp : (q == 2) ? -cp : sp;
}

namespace pg8 {
constexpr int BM = 256, BK = 64, HALF = 128, HTB = HALF * BK * 2, STAGE_BYTES = 8 * HTB, NXCD = 8, WGM = 8;
__host__ __device__ __forceinline__ int lds_byte(int r, int c) { const int st = (r >> 4) * 2 + (c >> 5), rr = r & 15, cc = c & 31, ob = rr * 64 + cc * 2; return st * 1024 + (ob ^ (((ob >> 9) & 1) << 5)); }
__host__ __device__ __forceinline__ void stage_rc(int b, int& R, int& C) { const int st = b / 1024, sb = b % 1024, swz = sb ^ (((sb >> 9) & 1) << 5); R = (st >> 1) * 16 + swz / 64; C = (st & 1) * 32 + (swz % 64) / 2; }
__host__ __device__ __forceinline__ int perm32(int rho) { const int n = rho >> 4, i = rho & 15; return 8 * (i >> 2) + 4 * n + (i & 3); }

struct Unit { int pm, pn, e, mt; };

struct StaticOrder {
    int nM, nN, nwg, G, c;
    __device__ void init(int M_, int N_, int G_, int c_) { nM = M_ / BM; nN = N_ / BM; nwg = nM * nN; G = G_; c = c_; }
    __device__ bool next(int i, Unit& u) const {
        const long L = (long)i * G + c; if (L >= nwg) return false;
        int wgid = (int)L; { const int q = nwg / NXCD, r = nwg % NXCD, xcd = wgid % NXCD, off = wgid / NXCD; wgid = (xcd < r ? xcd * (q + 1) : r * (q + 1) + (xcd - r) * q) + off; }
        const int nig = WGM * nN, gid = wgid / nig, fm = gid * WGM, gsz = (nM - fm) < WGM ? (nM - fm) : WGM;
        u.pm = fm + ((wgid % nig) % gsz); u.pn = (wgid % nig) / gsz; u.e = 0; u.mt = 0; return true;
    }
};
struct DenseSched : StaticOrder {
    const char* A; const char* Bt; size_t a_tstep, b_tstep;
    __device__ __forceinline__ const char* a_base(const Unit& u) const { return A + (size_t)u.pm * a_tstep; }
    __device__ __forceinline__ const char* b_base(const Unit& u) const { return Bt + (size_t)u.pn * b_tstep; }
    __device__ __forceinline__ unsigned a_row_off(const Unit&, int) const { return 0u; }
};

template <class Epi, class Sched, bool ALIGN_EPI, bool GATHER>
__device__ __forceinline__ void gemm_phase(LAS unsigned char* lds, const int K, const int lda, const int ldb, const Sched& S, const Epi& E) {
    const int tid = threadIdx.x, wid = __builtin_amdgcn_readfirstlane(tid >> 6), lane = tid & 63, wr = wid >> 2, wc = wid & 3, fr = lane & 15, fq = lane >> 4;
    const int nt = K / BK;
    unsigned voffA[2][2], nvoffA[2][2], voffB[2]; int RA[2], CA[2];
#pragma unroll
    for (int i = 0; i < 2; ++i) { int R, C; stage_rc(tid * 16 + i * 8192, R, C); const int Rb = Epi::PERM ? ((R & ~31) + perm32(R & 31)) : R;
        RA[i] = R; CA[i] = C; voffB[i] = (unsigned)(Rb * ldb + C) * 2u;
        voffA[0][i] = (unsigned)(R * lda + C) * 2u; voffA[1][i] = (unsigned)((R + HALF) * lda + C) * 2u; nvoffA[0][i] = voffA[0][i]; nvoffA[1][i] = voffA[1][i]; }
    const size_t kstep = (size_t)(BK * 2);
    const size_t hstepB = (size_t)HALF * ldb * 2;
    const unsigned ldsw = (unsigned)wid * 1024u;
    const int aoff = lds_byte(wr * 64 + fr, fq * 8), boff = lds_byte(wc * 32 + fr, fq * 8);
#define PG8_SA(b, h) (((b) * 2 + (h)) * HTB)
#define PG8_SB(b, h) ((4 + (b) * 2 + (h)) * HTB)
#define PG8_STAGE2(bufoff, gbase, v0, v1) do { \
        __builtin_amdgcn_global_load_lds((const unsigned*)((const char*)(gbase) + (v0)), (LAS unsigned*)(lds + (bufoff) + ldsw), 16, 0, 0); \
        __builtin_amdgcn_global_load_lds((const unsigned*)((const char*)(gbase) + (v1)), (LAS unsigned*)(lds + (bufoff) + ldsw + 8192), 16, 0, 0); } while (0)
#define PG8_STAGEB(bufoff, gbase) PG8_STAGE2(bufoff, gbase, voffB[0], voffB[1])
#define PG8_LDA(dst, b, h) do { _Pragma("unroll") for (int m = 0; m < 4; ++m) _Pragma("unroll") for (int k = 0; k < 2; ++k) dst[m][k] = *(const LAS bf16x8*)(lds + PG8_SA(b, h) + aoff + m * 2048 + k * 1024); } while (0)
#define PG8_LDB(dst, b, h) do { _Pragma("unroll") for (int n = 0; n < 2; ++n) _Pragma("unroll") for (int k = 0; k < 2; ++k) dst[n][k] = *(const LAS bf16x8*)(lds + PG8_SB(b, h) + boff + n * 2048 + k * 1024); } while (0)
#define PG8_MMA(ai, bj, At, Bt) do { __builtin_amdgcn_s_setprio(1); _Pragma("unroll") for (int m = 0; m < 4; ++m) _Pragma("unroll") for (int n = 0; n < 2; ++n) _Pragma("unroll") for (int k = 0; k < 2; ++k) \
        acc[ai][bj][m][n] = __builtin_amdgcn_mfma_f32_16x16x32_bf16(Bt[n][k], At[m][k], acc[ai][bj][m][n], 0, 0, 0); __builtin_amdgcn_s_setprio(0); } while (0)
#define PG8_WAIT_V(n) asm volatile("s_waitcnt vmcnt(" #n ")" ::: "memory")
#define PG8_WAIT_L(n) asm volatile("s_waitcnt lgkmcnt(" #n ")" ::: "memory")
#define PG8_BAR __builtin_amdgcn_s_barrier()
#define PG8_SCHED __builtin_amdgcn_sched_barrier(0)
    Unit cur, nxt; int ui = 0;
    if (!S.next(0, cur)) return;
    f32x4 acc[2][2][4][2];
#pragma unroll
    for (int a = 0; a < 2; ++a)
#pragma unroll
        for (int b = 0; b < 2; ++b)
#pragma unroll
            for (int m = 0; m < 4; ++m)
#pragma unroll
                for (int n = 0; n < 2; ++n) acc[a][b][m][n] = (f32x4){0.f, 0.f, 0.f, 0.f};
    bf16x8 At[4][2], B0[2][2], B1[2][2];
    const char* cA = S.a_base(cur); const char* cB = S.b_base(cur);
    if constexpr (GATHER) {
#pragma unroll
        for (int h = 0; h < 2; ++h)
#pragma unroll
            for (int i = 0; i < 2; ++i) voffA[h][i] = S.a_row_off(cur, h * HALF + RA[i]) + (unsigned)CA[i] * 2u;
        PG8_WAIT_V(0);
    }
    PG8_STAGEB(PG8_SB(0, 0), cB); PG8_STAGEB(PG8_SB(0, 1), cB + hstepB); PG8_STAGE2(PG8_SA(0, 0), cA, voffA[0][0], voffA[0][1]); PG8_STAGE2(PG8_SA(0, 1), cA, voffA[1][0], voffA[1][1]);
    if (wr == 1) PG8_BAR;
    PG8_WAIT_V(2); PG8_BAR;
    PG8_STAGEB(PG8_SB(1, 0), cB + kstep); PG8_STAGE2(PG8_SA(1, 0), cA + kstep, voffA[0][0], voffA[0][1]); PG8_STAGEB(PG8_SB(1, 1), cB + hstepB + kstep);
    PG8_WAIT_V(6); PG8_BAR;
    for (;;) {
        const bool has_next = S.next(ui + 1, nxt);
        const char* nA = has_next ? S.a_base(nxt) : cA; const char* nB = has_next ? S.b_base(nxt) : cB;
        if constexpr (GATHER) {
            if (has_next) {
#pragma unroll
                for (int h = 0; h < 2; ++h)
#pragma unroll
                    for (int i = 0; i < 2; ++i) nvoffA[h][i] = S.a_row_off(nxt, h * HALF + RA[i]) + (unsigned)CA[i] * 2u;
                PG8_WAIT_V(0);
            } else {
#pragma unroll
                for (int h = 0; h < 2; ++h)
#pragma unroll
                    for (int i = 0; i < 2; ++i) nvoffA[h][i] = voffA[h][i];
            }
        }
        for (int t = 0; t < nt; t += 2) {
            const bool last = (t == nt - 2);
            const char* a1 = cA + (size_t)(t + 1) * kstep;
            const char* a2 = last ? nA : cA + (size_t)(t + 2) * kstep; const char* b2 = last ? nB : cB + (size_t)(t + 2) * kstep;
            const char* a3 = a2 + kstep; const char* b3 = b2 + kstep;
            unsigned w00, w01, w10, w11;
            if constexpr (GATHER) { w00 = last ? nvoffA[0][0] : voffA[0][0]; w01 = last ? nvoffA[0][1] : voffA[0][1]; w10 = last ? nvoffA[1][0] : voffA[1][0]; w11 = last ? nvoffA[1][1] : voffA[1][1]; }
            else { w00 = voffA[0][0]; w01 = voffA[0][1]; w10 = voffA[1][0]; w11 = voffA[1][1]; }
            PG8_LDB(B0, 0, 0); PG8_LDB(B1, 0, 1); PG8_SCHED; PG8_LDA(At, 0, 0); PG8_STAGE2(PG8_SA(1, 1), a1, voffA[1][0], voffA[1][1]);
            PG8_WAIT_V(8); PG8_WAIT_L(0); PG8_BAR; PG8_MMA(0, 0, At, B0); PG8_MMA(0, 1, At, B1); PG8_BAR; PG8_SCHED;
            PG8_LDA(At, 0, 1); PG8_STAGEB(PG8_SB(0, 0), b2); PG8_STAGEB(PG8_SB(0, 1), b2 + hstepB); PG8_STAGE2(PG8_SA(0, 0), a2, w00, w01);
            PG8_WAIT_V(8); PG8_WAIT_L(0); PG8_BAR; PG8_MMA(1, 0, At, B0); PG8_MMA(1, 1, At, B1); PG8_BAR; PG8_SCHED;
            PG8_LDB(B0, 1, 0); PG8_LDB(B1, 1, 1); PG8_SCHED; PG8_LDA(At, 1, 0); PG8_STAGE2(PG8_SA(0, 1), a2, w10, w11);
            PG8_WAIT_V(8); PG8_WAIT_L(0); PG8_BAR; PG8_MMA(0, 0, At, B0); PG8_MMA(0, 1, At, B1); PG8_BAR; PG8_SCHED;
            PG8_LDA(At, 1, 1); PG8_STAGEB(PG8_SB(1, 0), b3); PG8_STAGEB(PG8_SB(1, 1), b3 + hstepB); PG8_STAGE2(PG8_SA(1, 0), a3, w00, w01);
            PG8_WAIT_V(8); PG8_WAIT_L(0); PG8_BAR; PG8_MMA(1, 0, At, B0); PG8_MMA(1, 1, At, B1); PG8_BAR; PG8_SCHED;
        }
        if constexpr (ALIGN_EPI) { if (wr == 0) PG8_BAR; }
        E(acc, cur, wr, wc, fr, fq);
        if (!has_next) break;
#pragma unroll
        for (int a = 0; a < 2; ++a)
#pragma unroll
            for (int b = 0; b < 2; ++b)
#pragma unroll
                for (int m = 0; m < 4; ++m)
#pragma unroll
                    for (int n = 0; n < 2; ++n) acc[a][b][m][n] = (f32x4){0.f, 0.f, 0.f, 0.f};
        cur = nxt; cA = nA; cB = nB; ++ui;
        if constexpr (GATHER) {
#pragma unroll
            for (int h = 0; h < 2; ++h)
#pragma unroll
                for (int i = 0; i < 2; ++i) voffA[h][i] = nvoffA[h][i];
        }
        if constexpr (ALIGN_EPI) { if (wr == 1) PG8_BAR; }
    }
    PG8_WAIT_V(0);
    if constexpr (!ALIGN_EPI) { if (wr == 0) PG8_BAR; }
    PG8_BAR;
#undef PG8_SA
#undef PG8_SB
#undef PG8_STAGE2
#undef PG8_STAGEB
#undef PG8_LDA
#undef PG8_LDB
#undef PG8_MMA
#undef PG8_WAIT_V
#undef PG8_WAIT_L
#undef PG8_BAR
#undef PG8_SCHED
}

typedef f32x4 Acc[2][2][4][2];
__device__ __forceinline__ u32x4 pack8(f32x4 v0, f32x4 v1) { u32x4 w; w.x = cvt_pk_bf16(v0[0], v0[1]); w.y = cvt_pk_bf16(v0[2], v0[3]); w.z = cvt_pk_bf16(v1[0], v1[1]); w.w = cvt_pk_bf16(v1[2], v1[3]); return w; }
__device__ __forceinline__ void unpack8(u32x4 w, f32x4& v0, f32x4& v1) { v0 = (f32x4){bflo(w.x), bfhi(w.x), bflo(w.y), bfhi(w.y)}; v1 = (f32x4){bflo(w.z), bfhi(w.z), bflo(w.w), bfhi(w.w)}; }
__device__ __forceinline__ f32x4 sig4(f32x4 v) { return (f32x4){sigmoidf_(v[0]), sigmoidf_(v[1]), sigmoidf_(v[2]), sigmoidf_(v[3])}; }

struct EpiInProj {
    static constexpr bool PERM = true;
    bf16 *Q, *Kk, *V, *U, *GA, *GB;
    __device__ __forceinline__ void operator()(const Acc& acc, const Unit& u, int wr, int wc, int fr, int fq) const {
        const int pn = u.pn, row0 = u.pm * BM + wr * 64 + fr, ct = wc * 32 + 8 * fq;
        bf16* base; int ldc, colb, mode;
        if (pn < 2) { base = Q; ldc = AW; colb = pn * 256; mode = 1; }
        else if (pn < 4) { base = Kk; ldc = AW; colb = (pn - 2) * 256; mode = 0; }
        else if (pn < 6) { base = V; ldc = AW; colb = (pn - 4) * 256; mode = 0; }
        else if (pn < 8) { base = U; ldc = 0; colb = (pn - 6) * 256; mode = 3; }
        else if (pn < 12) { base = GA; ldc = D; colb = (pn - 8) * 256; mode = 2; }
        else { base = GB; ldc = D; colb = (pn - 12) * 256; mode = 2; }
#pragma unroll
        for (int ai = 0; ai < 2; ++ai)
#pragma unroll
            for (int m = 0; m < 4; ++m) { const int row = row0 + ai * HALF + m * 16;
#pragma unroll
                for (int bj = 0; bj < 2; ++bj) { f32x4 v0 = acc[ai][bj][m][0], v1 = acc[ai][bj][m][1]; const int col = colb + bj * HALF + ct;
                    if (mode == 1) { v0 = v0 * QSCALE; v1 = v1 * QSCALE; }
                    if (mode == 2) { v0 = sig4(v0); v1 = sig4(v1); }
                    bf16* p = (mode == 3) ? base + ((size_t)(col >> 4) * M + row) * 16 + (col & 15) : base + (size_t)row * ldc + col;
                    *(u32x4*)p = pack8(v0, v1); } }
    }
};
template <int MODE> struct EpiGate {
    static constexpr bool PERM = true;
    bf16* O; const bf16* X; const bf16* G; const float* bias; int ldc;
    __device__ __forceinline__ void operator()(const Acc& acc, const Unit& u, int wr, int wc, int fr, int fq) const {
        const int row0 = u.pm * BM + wr * 64 + fr, col0 = u.pn * BM + wc * 32 + 8 * fq;
#pragma unroll
        for (int ai = 0; ai < 2; ++ai)
#pragma unroll
            for (int m = 0; m < 4; ++m) { const size_t ro = (size_t)(row0 + ai * HALF + m * 16) * ldc;
#pragma unroll
                for (int bj = 0; bj < 2; ++bj) { f32x4 v0 = acc[ai][bj][m][0], v1 = acc[ai][bj][m][1]; const int col = col0 + bj * HALF; f32x4 x0, x1, g0, g1;
                    if (MODE == 0) { const f32x4 b0 = *(const f32x4*)(bias + col), b1 = *(const f32x4*)(bias + col + 4); unpack8(*(const u32x4*)(X + ro + col), x0, x1); v0 = x0 * sig4(v0 + b0); v1 = x1 * sig4(v1 + b1); }
                    if (MODE == 1) { unpack8(*(const u32x4*)(G + ro + col), g0, g1); v0 = v0 * g0; v1 = v1 * g1; }
                    if (MODE == 2) { unpack8(*(const u32x4*)(G + ro + col), g0, g1); unpack8(*(const u32x4*)(X + ro + col), x0, x1); v0 = x0 + v0 * g0; v1 = x1 + v1 * g1; }
                    *(u32x4*)(O + ro + col) = pack8(v0, v1); } }
    }
};
struct EpiMix {
    static constexpr bool PERM = false;
    float* O; const bf16* XN;
    __device__ __forceinline__ void operator()(const Acc& acc, const Unit& u, int wr, int wc, int fr, int fq) const {
        const int row0 = u.pm * BM + wr * 64 + fr, col0 = u.pn * BM + wc * 32 + 4 * fq;
#pragma unroll
        for (int ai = 0; ai < 2; ++ai)
#pragma unroll
            for (int m = 0; m < 4; ++m) { const size_t ro = (size_t)(row0 + ai * HALF + m * 16) * D;
#pragma unroll
                for (int bj = 0; bj < 2; ++bj)
#pragma unroll
                    for (int n = 0; n < 2; ++n) { const int col = col0 + bj * HALF + n * 16; const u32x2 h = *(const u32x2*)(XN + ro + col);
                        const f32x4 hv = (f32x4){bflo(h.x), bfhi(h.x), bflo(h.y), bfhi(h.y)};
                        *(f32x4*)(O + ro + col) = hv * ALPHA + acc[ai][bj][m][n]; } }
    }
};
struct EpiMoe1 {
    static constexpr bool PERM = true;
    bf16* ACT; const float* bg; const float* bu;
    __device__ __forceinline__ void operator()(const Acc& acc, const Unit& u, int wr, int wc, int fr, int fq) const {
        const int row0 = u.pm * BM + wr * 64 + fr, col = u.pn * HALF + wc * 32 + 8 * fq;
        const float* pg = bg + (size_t)u.e * D + col; const float* pu = bu + (size_t)u.e * D + col;
        const f32x4 g0 = *(const f32x4*)pg, g1 = *(const f32x4*)(pg + 4), u0 = *(const f32x4*)pu, u1 = *(const f32x4*)(pu + 4);
#pragma unroll
        for (int ai = 0; ai < 2; ++ai)
#pragma unroll
            for (int m = 0; m < 4; ++m) { const size_t ro = (size_t)(row0 + ai * HALF + m * 16) * D;
                f32x4 ga = acc[ai][0][m][0] + g0, gb = acc[ai][0][m][1] + g1, ua = acc[ai][1][m][0] + u0, ub = acc[ai][1][m][1] + u1;
#pragma unroll
                for (int i = 0; i < 4; ++i) { const float g_ = fminf(ga[i], SW_LIMIT), u_ = fminf(fmaxf(ua[i], -SW_LIMIT), SW_LIMIT); ga[i] = (u_ + 1.0f) * g_ * sigmoidf_(SW_ALPHA * g_);
                    const float g2 = fminf(gb[i], SW_LIMIT), u2 = fminf(fmaxf(ub[i], -SW_LIMIT), SW_LIMIT); gb[i] = (u2 + 1.0f) * g2 * sigmoidf_(SW_ALPHA * g2); }
                *(u32x4*)(ACT + ro + col) = pack8(ga, gb); }
    }
};
struct EpiMoe2 {
    static constexpr bool PERM = true;
    bf16* YS; const float* bd; const int* list; const float* wslot; const LAS int* tab;
    __device__ __forceinline__ void operator()(const Acc& acc, const Unit& u, int wr, int wc, int fr, int fq) const {
        const int r0 = wr * 64 + fr, col0 = u.pn * BM + wc * 32 + 8 * fq, cnt = tab[40 + u.e];
        const float* pb = bd + (size_t)u.e * D + col0;
        f32x4 b[2][2];
#pragma unroll
        for (int bj = 0; bj < 2; ++bj) { b[bj][0] = *(const f32x4*)(pb + bj * HALF); b[bj][1] = *(const f32x4*)(pb + bj * HALF + 4); }
#pragma unroll
        for (int ai = 0; ai < 2; ++ai)
#pragma unroll
            for (int m = 0; m < 4; ++m) { const int rr = u.mt * BM + r0 + ai * HALF + m * 16;
                if (rr < cnt) { const int slot = list[(size_t)u.e * LIST_CAP + rr]; const float w = wslot[slot];
#pragma unroll
                    for (int bj = 0; bj < 2; ++bj) { const f32x4 v0 = (acc[ai][bj][m][0] + b[bj][0]) * w, v1 = (acc[ai][bj][m][1] + b[bj][1]) * w;
                        *(u32x4*)(YS + (size_t)slot * D + col0 + bj * HALF) = pack8(v0, v1); } } }
    }
};
struct MoeSched {
    const LAS int* tab; int G, c, npn, total;
    const char* A; const char* Bt; size_t a_tstep, b_estep, b_tstep; const int* list;
    __device__ __forceinline__ bool next(int i, Unit& u) const {
        const int L = i * G + c; if (L >= total) return false;
        const int tau = L / npn; u.pn = L - tau * npn; int e = 0;
        for (int j = 1; j < NE; ++j) if (tab[j] <= tau) e = j;
        u.e = e; u.pm = tau; u.mt = tau - tab[e]; return true;
    }
    __device__ __forceinline__ const char* a_base(const Unit& u) const { return A + (size_t)u.pm * a_tstep; }
    __device__ __forceinline__ const char* b_base(const Unit& u) const { return Bt + (size_t)u.e * b_estep + (size_t)u.pn * b_tstep; }
    __device__ __forceinline__ unsigned a_row_off(const Unit& u, int r) const {
        const int rr = u.mt * BM + r; const int cnt = tab[40 + u.e]; int tok = 0;
        if (rr < cnt) tok = list[(size_t)u.e * LIST_CAP + rr] >> 2;
        return (unsigned)tok * (unsigned)(D * 2);
    }
};
}

#define XB_TMO      128
#define XB_XCNT(j)  (256  + 64 * (j))
#define XB_XSUB(j)  (1280 + 64 * (j))
#define XB_XGEN(j)  (2304 + 64 * (j))
#define XB_TOP      3328
#define XB_TOPGEN   3392
#define XCD_BAR_WORDS 3456
#define XB_SPIN_CAP (1u << 18)
__device__ __forceinline__ unsigned xb_ld(unsigned* p)              { return __hip_atomic_load(p, __ATOMIC_RELAXED, __HIP_MEMORY_SCOPE_AGENT); }
__device__ __forceinline__ unsigned xb_add(unsigned* p, unsigned v) { return __hip_atomic_fetch_add(p, v, __ATOMIC_RELAXED, __HIP_MEMORY_SCOPE_AGENT); }
__device__ __forceinline__ unsigned xb_xcc_id() { return (unsigned)__builtin_amdgcn_s_getreg((3 << 11) | 20) & 0xFu; }
#define XB_SPIN(cond, bar) do { unsigned _sp = 0; while (cond) { __builtin_amdgcn_s_sleep(1); \
    if ((++_sp & 255u) == 0u) { if (xb_ld(&(bar)[XB_TMO])) break; if (_sp > XB_SPIN_CAP) { atomicAdd(&(bar)[XB_TMO], 1u); break; } } } } while (0)
struct XcdBarrier { unsigned* bar; unsigned x; volatile LAS unsigned* st; };
__device__ __forceinline__ XcdBarrier xcd_barrier_post(unsigned* bar, volatile LAS unsigned* st) {
    XcdBarrier b; b.bar = bar; b.x = xb_xcc_id(); b.st = st;
    if (threadIdx.x == 0) (void)xb_add(&bar[XB_XCNT(b.x)], 1u);
    return b;
}
__device__ __forceinline__ void xcd_barrier_complete(unsigned* bar, unsigned x, unsigned& nloc, unsigned& nx) {
    const unsigned G = gridDim.x * gridDim.y * gridDim.z;
    unsigned sum, cnt, mine, sp = 0u;
    for (;;) {
        sum = 0u; cnt = 0u; mine = 0u;
#pragma unroll
        for (unsigned j = 0; j < 16; ++j) { const unsigned c = xb_ld(&bar[XB_XCNT(j)]); sum += c; cnt += (c > 0u) ? 1u : 0u; mine = (j == x) ? c : mine; }
        if (sum == G) break;
        __builtin_amdgcn_s_sleep(1);
        if ((++sp & 255u) == 0u) { if (xb_ld(&bar[XB_TMO])) break; if (sp > XB_SPIN_CAP) { atomicAdd(&bar[XB_TMO], 1u); break; } }
    }
    nloc = mine > 0u ? mine : 1u; nx = cnt > 0u ? cnt : 1u;
}
__device__ __forceinline__ void xcd_barrier(const XcdBarrier& b) {
    asm volatile("s_waitcnt vmcnt(0)" ::: "memory");
    __syncthreads();
    if (threadIdx.x == 0) {
        unsigned* bar = b.bar;
        __builtin_amdgcn_s_waitcnt(0);
        unsigned nloc = b.st[0], nx = b.st[1];
        if (nloc == 0u) { xcd_barrier_complete(bar, b.x, nloc, nx); b.st[0] = nloc; b.st[1] = nx; }
        const unsigned old = xb_add(&bar[XB_XSUB(b.x)], 1u);
        const unsigned gen = old / nloc;
        if (old + 1u == (gen + 1u) * nloc) {
            __builtin_amdgcn_fence(__ATOMIC_RELEASE, "agent");
            asm volatile("s_waitcnt vmcnt(0)" ::: "memory");
            const unsigned og = xb_add(&bar[XB_TOP], 1u);
            const unsigned tg = og / nx;
            if (og + 1u == (tg + 1u) * nx) xb_add(&bar[XB_TOPGEN], 1u);
            else XB_SPIN(xb_ld(&bar[XB_TOPGEN]) == tg, bar);
            __builtin_amdgcn_fence(__ATOMIC_ACQUIRE, "agent");
            xb_add(&bar[XB_XGEN(b.x)], 1u);
            asm volatile("s_waitcnt vmcnt(0)" ::: "memory");
        } else {
            XB_SPIN(xb_ld(&bar[XB_XGEN(b.x)]) == gen, bar);
            __builtin_amdgcn_fence(__ATOMIC_ACQUIRE, "agent");
            asm volatile("s_waitcnt vmcnt(0)" ::: "memory");
        }
    }
    __syncthreads();
}

struct Frame {
    LAS unsigned char* lds; volatile LAS unsigned* MISC; unsigned* ctl; unsigned char* ws;
    int vcu, G;
    const float* in[31]; float* out;
};
enum InIdx { I_X = 0, I_META, I_LNG, I_LNB, I_WIN, I_BF, I_WUPA, I_WUPB, I_WO, I_ARE, I_AIM, I_LOGDT, I_BRE, I_BIM, I_CRE, I_CIM, I_SD, I_WGLU, I_BGLU, I_LN1G, I_LN1B,
             I_WR, I_BR, I_WG, I_BG, I_WU, I_BU, I_WD, I_BD, I_LN2G, I_LN2B };

__device__ __forceinline__ void p0_transpose_item(const float* W, int ldw, int K, int k0, int n0s, bf16* WT, int drow0, LAS float* scr, int lane) {
#pragma unroll 8
    for (int i = 0; i < 32; ++i) { const int kk = 2 * i + (lane >> 5); scr[kk * 33 + (lane & 31)] = W[(size_t)(k0 + kk) * ldw + n0s + (lane & 31)]; }
    LDS_WAIT(); asm volatile("" ::: "memory");
    const int c = lane & 7;
#pragma unroll
    for (int j = 0; j < 4; ++j) { const int n = (lane >> 3) + 8 * j; const LAS float* s = scr + (8 * c) * 33 + n;
        u32x4 o; o.x = pk2(s[0 * 33], s[1 * 33]); o.y = pk2(s[2 * 33], s[3 * 33]); o.z = pk2(s[4 * 33], s[5 * 33]); o.w = pk2(s[6 * 33], s[7 * 33]);
        *(u32x4*)(WT + (size_t)(drow0 + n) * K + k0 + 8 * c) = o; }
    LDS_WAIT(); asm volatile("" ::: "memory");
}
__device__ __forceinline__ void ln_row_stats(const float* xrow, int lane, f32x4 (&v)[4]) {
    const f32x4* xr = (const f32x4*)xrow + lane; float s = 0.f;
#pragma unroll
    for (int j = 0; j < 4; ++j) { v[j] = xr[64 * j]; s += (v[j].x + v[j].y) + (v[j].z + v[j].w); }
    const float mean = wave_sum(s) * (1.f / D); float s2 = 0.f;
#pragma unroll
    for (int j = 0; j < 4; ++j) { v[j] = v[j] - mean; s2 += (v[j].x * v[j].x + v[j].y * v[j].y) + (v[j].z * v[j].z + v[j].w * v[j].w); }
    const float rstd = 1.f / sqrtf(wave_sum(s2) * (1.f / D) + LN_EPS);
#pragma unroll
    for (int j = 0; j < 4; ++j) v[j] = v[j] * rstd;
}

__device__ __forceinline__ void p0_prologue(Frame& F) {
    const int tid_ = fresh_tid(), lane = tid_ & 63, wave = __builtin_amdgcn_readfirstlane(tid_ >> 6);
    const float* lng = F.in[I_LNG]; const float* lnb = F.in[I_LNB]; const float* w_in = F.in[I_WIN];
    f32x4 gv[4], bv[4];
#pragma unroll
    for (int j = 0; j < 4; ++j) { gv[j] = *((const f32x4*)lng + lane + 64 * j); bv[j] = *((const f32x4*)lnb + lane + 64 * j); }
    if (blockIdx.x < 25) {
        LAS float* hm = (LAS float*)F.lds;
        LAS float* red = (LAS float*)(F.lds + 65536);
#pragma unroll
        for (int rr = 0; rr < 2; ++rr) { const int r = 2 * wave + rr; f32x4 v[4]; ln_row_stats(F.in[I_META] + (size_t)r * D, lane, v);
#pragma unroll
            for (int j = 0; j < 4; ++j) { const f32x4 h = v[j] * gv[j] + bv[j]; const int k = 256 * j + 4 * lane;
                hm[(k + 0) * 16 + r] = h.x; hm[(k + 1) * 16 + r] = h.y; hm[(k + 2) * 16 + r] = h.z; hm[(k + 3) * 16 + r] = h.w; } }
        __syncthreads();
        const int col = 512 + 64 * (int)blockIdx.x + lane; const bool valid = col < GA_OFF;
        float acc[16];
#pragma unroll
        for (int r = 0; r < 16; ++r) acc[r] = 0.f;
        for (int k = 128 * wave; k < 128 * wave + 128; ++k) { const float wv = valid ? w_in[(size_t)k * IN_COLS + col] : 0.f;
            const LAS f32x4* hp = (const LAS f32x4*)(hm + k * 16);
#pragma unroll
            for (int q = 0; q < 4; ++q) { const f32x4 h = hp[q]; acc[4 * q + 0] += h.x * wv; acc[4 * q + 1] += h.y * wv; acc[4 * q + 2] += h.z * wv; acc[4 * q + 3] += h.w * wv; } }
#pragma unroll
        for (int r = 0; r < 16; ++r) red[(wave * 16 + r) * 64 + lane] = acc[r];
        __syncthreads();
        unsigned char* sm = F.ws + WS_SMALL;
#pragma unroll
        for (int rr = 0; rr < 2; ++rr) { const int r = 2 * wave + rr; float s = 0.f;
#pragma unroll
            for (int w = 0; w < 8; ++w) s += red[(w * 16 + r) * 64 + lane];
            if (valid) {
                if (col < 1024) ((bf16*)(sm + SM_KMETA))[r * AW + col - 512] = (bf16)f2bf(s);
                else if (col < F_OFF) ((bf16*)(sm + SM_VMETA))[r * AW + col - 1024] = (bf16)f2bf(s);
                else if (col < U_OFF) ((float*)(sm + SM_LOGFM))[r * 8 + col - F_OFF] = log_sigmoidf_(s + F.in[I_BF][col - F_OFF]);
                else ((float*)(sm + SM_UMETA))[r * SW + col - U_OFF] = s;
            } }
        __syncthreads();
    }
    {
        LAS float* scr = (LAS float*)(F.lds + wave * 16384);
        const int gw = F.vcu * NWAVES + wave, NGW = F.G * NWAVES;
        constexpr int I_IN = 16 * 128, I_UA = 8 * 32, I_UB = 8 * 32, I_O = 16 * 32, I_GL = 8 * 16, I_GU = 16 * 64, I_DN = 16 * 32;
        constexpr int NDENSE = I_IN + I_UA + I_UB + I_O + I_GL, NITEMS = NDENSE + NE * (I_GU + I_DN);
        for (int it = gw; it < NITEMS; it += NGW) {
            int r = it;
            if (r < I_IN) { const int kb = r / 128, nb = r % 128, n0 = 32 * nb; p0_transpose_item(w_in, IN_COLS, D, 64 * kb, n0 + (n0 >= F_OFF ? 8 : 0), (bf16*)(F.ws + WS_WIN), n0, scr, lane); continue; } r -= I_IN;
            if (r < I_UA) { const int kb = r / 32, nb = r % 32; p0_transpose_item(F.in[I_WUPA], D, AW, 64 * kb, 32 * nb, (bf16*)(F.ws + WS_WUPA), 32 * nb, scr, lane); continue; } r -= I_UA;
            if (r < I_UB) { const int kb = r / 32, nb = r % 32; p0_transpose_item(F.in[I_WUPB], D, SW, 64 * kb, 32 * nb, (bf16*)(F.ws + WS_WUPB), 32 * nb, scr, lane); continue; } r -= I_UB;
            if (r < I_O) { const int kb = r / 32, nb = r % 32; p0_transpose_item(F.in[I_WO], D, D, 64 * kb, 32 * nb, (bf16*)(F.ws + WS_WO), 32 * nb, scr, lane); continue; } r -= I_O;
            if (r < I_GL) { const int kb = r / 16, nb = r % 16; p0_transpose_item(F.in[I_WGLU], SW, SW, 64 * kb, 32 * nb, (bf16*)(F.ws + WS_WGLU), 32 * nb, scr, lane); continue; } r -= I_GL;
            const int e = r / (I_GU + I_DN); r -= e * (I_GU + I_DN);
            if (r < I_GU) { const int kb = r / 64, nb = r % 64, dr = 32 * nb, pn = dr >> 8, jj = dr & 255;
                const float* src = (jj < 128 ? F.in[I_WG] : F.in[I_WU]) + (size_t)e * D * D; const int sc = pn * 128 + (jj & 127);
                p0_transpose_item(src, D, D, 64 * kb, sc, (bf16*)(F.ws + WS_WGU) + (size_t)e * 2048 * D, dr, scr, lane); continue; } r -= I_GU;
            { const int kb = r / 32, nb = r % 32; p0_transpose_item(F.in[I_WD] + (size_t)e * D * D, D, D, 64 * kb, 32 * nb, (bf16*)(F.ws + WS_WD) + (size_t)e * D * D, 32 * nb, scr, lane); }
        }
        float wf[16][8];
#pragma unroll
        for (int j = 0; j < 4; ++j)
#pragma unroll
            for (int i = 0; i < 4; ++i) { const float* p = w_in + (size_t)(256 * j + 4 * lane + i) * IN_COLS + F_OFF; const f32x4 a = *(const f32x4*)p, b = *(const f32x4*)(p + 4);
                wf[4 * j + i][0] = a.x; wf[4 * j + i][1] = a.y; wf[4 * j + i][2] = a.z; wf[4 * j + i][3] = a.w; wf[4 * j + i][4] = b.x; wf[4 * j + i][5] = b.y; wf[4 * j + i][6] = b.z; wf[4 * j + i][7] = b.w; }
        const float bfl = F.in[I_BF][lane & 7];
        bf16* XN = (bf16*)(F.ws + WS_XN); float* logf = (float*)(F.ws + WS_LOGF);
        for (int m = gw; m < M; m += NGW) {
            f32x4 v[4]; ln_row_stats(F.in[I_X] + (size_t)m * D, lane, v);
            float fs[8];
#pragma unroll
            for (int h = 0; h < 8; ++h) fs[h] = 0.f;
            unsigned long long* o8 = (unsigned long long*)(XN + (size_t)m * D) + lane;
#pragma unroll
            for (int j = 0; j < 4; ++j) { const f32x4 h = v[j] * gv[j] + bv[j];
                o8[64 * j] = (unsigned long long)pk2(h.x, h.y) | ((unsigned long long)pk2(h.z, h.w) << 32);
#pragma unroll
                for (int hh = 0; hh < 8; ++hh) fs[hh] += h.x * wf[4 * j + 0][hh] + h.y * wf[4 * j + 1][hh] + h.z * wf[4 * j + 2][hh] + h.w * wf[4 * j + 3][hh]; }
#pragma unroll
            for (int hh = 0; hh < 8; ++hh) fs[hh] = wave_sum(fs[hh]);
            const int l7 = lane & 7;
            const float mine = (l7 == 0) ? fs[0] : (l7 == 1) ? fs[1] : (l7 == 2) ? fs[2] : (l7 == 3) ? fs[3] : (l7 == 4) ? fs[4] : (l7 == 5) ? fs[5] : (l7 == 6) ? fs[6] : fs[7];
            if (lane < 8) logf[(size_t)m * 8 + lane] = log_sigmoidf_(mine + bfl);
        }
    }
}

__device__ __forceinline__ void p1_fcumsum(Frame& F) {
    const int tid_ = fresh_tid(), lane = tid_ & 63, wave_ = __builtin_amdgcn_readfirstlane(tid_ >> 6);
    if (blockIdx.x >= 16 || wave_ != 0) return;
    const int b = blockIdx.x >> 3, h = blockIdx.x & 7;
    const float* logfm = (const float*)(F.ws + WS_SMALL + SM_LOGFM); float* F2m = (float*)(F.ws + WS_SMALL + SM_F2M);
    float mt = 0.f;
    for (int j = 0; j < NMETA; ++j) { mt += logfm[j * 8 + h]; if (b == 0 && lane == 0) F2m[h * 16 + j] = mt * LOG2E; }
    const float* lf = (const float*)(F.ws + WS_LOGF) + (size_t)b * SEQ * 8 + h; float* F2x = (float*)(F.ws + WS_F2X) + (size_t)(b * 8 + h) * SEQ;
    float s = 0.f;
    for (int i = 0; i < 128; ++i) s += lf[(size_t)(128 * lane + i) * 8];
    float inc = s;
#pragma unroll
    for (int o = 1; o < 64; o <<= 1) { const float t = __shfl_up(inc, o); if (lane >= o) inc += t; }
    float run = mt + (inc - s);
    for (int i = 0; i < 128; ++i) { run += lf[(size_t)(128 * lane + i) * 8]; F2x[128 * lane + i] = run * LOG2E; }
}

__device__ __forceinline__ void p2_attention_naive(Frame& F) {
    const int tid = fresh_tid(), wave_ = __builtin_amdgcn_readfirstlane(tid >> 6);
    const int c = blockIdx.x, bh = c >> 4, qblk = c & 15, b = bh >> 3, h = bh & 7;
    const int t = qblk * 512 + tid; const size_t m = (size_t)b * SEQ + t;
    const bf16* Q = (const bf16*)(F.ws + WS_Q); const bf16* Kx = (const bf16*)(F.ws + WS_K); const bf16* Vx = (const bf16*)(F.ws + WS_V);
    const bf16* Km = (const bf16*)(F.ws + WS_SMALL + SM_KMETA); const bf16* Vm = (const bf16*)(F.ws + WS_SMALL + SM_VMETA);
    const float* F2x = (const float*)(F.ws + WS_F2X) + (size_t)(b * 8 + h) * SEQ; const float* F2m = (const float*)(F.ws + WS_SMALL + SM_F2M) + h * 16;
    LAS float* Ks = (LAS float*)F.lds; LAS float* Vs = Ks + 64 * 64; LAS float* Fs = Vs + 64 * 64;
    float q[64], o[64];
#pragma unroll
    for (int i = 0; i < 8; ++i) { const u32x4 w = *(const u32x4*)(Q + m * AW + h * HD + 8 * i); f32x4 a, bq; pg8::unpack8(w, a, bq);
        q[8 * i + 0] = a[0]; q[8 * i + 1] = a[1]; q[8 * i + 2] = a[2]; q[8 * i + 3] = a[3]; q[8 * i + 4] = bq[0]; q[8 * i + 5] = bq[1]; q[8 * i + 6] = bq[2]; q[8 * i + 7] = bq[3]; }
#pragma unroll
    for (int d = 0; d < 64; ++d) o[d] = 0.f;
    const float fq = F2x[t]; float mx = -1e30f, l = 0.f;
    const int ntile = (qblk * 512 + 512) / 64; const int wave_tmax = qblk * 512 + wave_ * 64 + 63;
    for (int kt = -1; kt < ntile; ++kt) {
        __syncthreads();
        const int nk = (kt < 0) ? NMETA : 64;
        { const int j = tid >> 3, ch = tid & 7;
          if (j < nk) { const bf16* kp = (kt < 0) ? Km + (size_t)j * AW : Kx + ((size_t)b * SEQ + kt * 64 + j) * AW; const bf16* vp = (kt < 0) ? Vm + (size_t)j * AW : Vx + ((size_t)b * SEQ + kt * 64 + j) * AW;
              f32x4 a, bq; pg8::unpack8(*(const u32x4*)(kp + h * HD + 8 * ch), a, bq); *(LAS f32x4*)(Ks + j * 64 + 8 * ch) = a; *(LAS f32x4*)(Ks + j * 64 + 8 * ch + 4) = bq;
              pg8::unpack8(*(const u32x4*)(vp + h * HD + 8 * ch), a, bq); *(LAS f32x4*)(Vs + j * 64 + 8 * ch) = a; *(LAS f32x4*)(Vs + j * 64 + 8 * ch + 4) = bq; }
          if (tid < nk) Fs[tid] = (kt < 0) ? F2m[tid] : F2x[kt * 64 + tid]; }
        __syncthreads();
        if (kt >= 0 && kt * 64 > wave_tmax) continue;
        for (int j = 0; j < nk; ++j) {
            const LAS f32x4* kr = (const LAS f32x4*)(Ks + j * 64); float s0 = 0.f, s1 = 0.f;
#pragma unroll
            for (int i = 0; i < 16; i += 2) { const f32x4 k0 = kr[i], k1 = kr[i + 1];
                s0 += q[4 * i] * k0.x + q[4 * i + 1] * k0.y + q[4 * i + 2] * k0.z + q[4 * i + 3] * k0.w; s1 += q[4 * i + 4] * k1.x + q[4 * i + 5] * k1.y + q[4 * i + 6] * k1.z + q[4 * i + 7] * k1.w; }
            float s = s0 + s1 + (fq - Fs[j]);
            const bool ok = (kt < 0) || (kt * 64 + j <= t);
            s = ok ? s : -INFINITY;
            const float mn = fmaxf(mx, s), corr = __builtin_amdgcn_exp2f(mx - mn), p = __builtin_amdgcn_exp2f(s - mn);
            mx = mn; l = l * corr + p;
            const LAS f32x4* vr = (const LAS f32x4*)(Vs + j * 64);
#pragma unroll
            for (int i = 0; i < 16; ++i) { const f32x4 vv = vr[i]; o[4 * i] = o[4 * i] * corr + p * vv.x; o[4 * i + 1] = o[4 * i + 1] * corr + p * vv.y; o[4 * i + 2] = o[4 * i + 2] * corr + p * vv.z; o[4 * i + 3] = o[4 * i + 3] * corr + p * vv.w; }
        }
    }
    const float rl = 1.0f / l; bf16* Ya = (bf16*)(F.ws + WS_YA) + m * AW + h * HD;
#pragma unroll
    for (int i = 0; i < 8; ++i) { u32x4 w; w.x = pk2(o[8 * i] * rl, o[8 * i + 1] * rl); w.y = pk2(o[8 * i + 2] * rl, o[8 * i + 3] * rl); w.z = pk2(o[8 * i + 4] * rl, o[8 * i + 5] * rl); w.w = pk2(o[8 * i + 6] * rl, o[8 * i + 7] * rl);
        *(u32x4*)(Ya + 8 * i) = w; }
    __syncthreads();
}

__device__ __forceinline__ void p2_ssm_seq(Frame& F) {
    const int tid_ = fresh_tid(), lane = tid_ & 63, wave_ = __builtin_amdgcn_readfirstlane(tid_ >> 6);
    if (blockIdx.x >= 64 || wave_ != 0) return;
    const int b = blockIdx.x >> 5, g = blockIdx.x & 31, p = lane;
    const float dt = __expf(F.in[I_LOGDT][g]); const float are = F.in[I_ARE][g * NP + p], aim = F.in[I_AIM][g * NP + p];
    const float mag = __expf(are * dt); float sn, cs; sincos_acc(aim * dt, sn, cs);
    const float lbr = mag * cs, lbi = mag * sn, den = are * are + aim * aim, zr = lbr - 1.0f, zi = lbi;
    const float cfr = (zr * are + zi * aim) / den, cfi = (zi * are - zr * aim) / den;
    float bbr[16], bbi[16], cr[16], ci[16];
#pragma unroll
    for (int c = 0; c < 16; ++c) { const float br = F.in[I_BRE][((size_t)g * NP + p) * GC + c], bi = F.in[I_BIM][((size_t)g * NP + p) * GC + c];
        bbr[c] = cfr * br - cfi * bi; bbi[c] = cfr * bi + cfi * br;
        cr[c] = F.in[I_CRE][((size_t)g * GC + c) * NP + p]; ci[c] = F.in[I_CIM][((size_t)g * GC + c) * NP + p]; }
    const int cmine = (lane >> 2) & 15; const float dsk = F.in[I_SD][g * GC + cmine];
    const bool b5 = lane & 32, b4 = lane & 16, b3 = lane & 8, b2 = lane & 4;
    const float* Um = (const float*)(F.ws + WS_SMALL + SM_UMETA) + g * GC;
    const bf16* U = (const bf16*)(F.ws + WS_U) + ((size_t)g * M + (size_t)b * SEQ) * 16;
    bf16* Yb = (bf16*)(F.ws + WS_YB) + (size_t)b * SEQ * SW + g * GC;
    float xr = 0.f, xi = 0.f;
    for (int t = -NMETA; t < SEQ; ++t) {
        float u[16]; float umine;
        if (t < 0) {
#pragma unroll
            for (int c = 0; c < 16; ++c) u[c] = Um[(size_t)(t + NMETA) * SW + c];
            umine = 0.f;
        } else { const u32x4 w0 = *(const u32x4*)(U + (size_t)t * 16), w1 = *(const u32x4*)(U + (size_t)t * 16 + 8); f32x4 a0, a1, a2, a3; pg8::unpack8(w0, a0, a1); pg8::unpack8(w1, a2, a3);
            u[0] = a0[0]; u[1] = a0[1]; u[2] = a0[2]; u[3] = a0[3]; u[4] = a1[0]; u[5] = a1[1]; u[6] = a1[2]; u[7] = a1[3]; u[8] = a2[0]; u[9] = a2[1]; u[10] = a2[2]; u[11] = a2[3]; u[12] = a3[0]; u[13] = a3[1]; u[14] = a3[2]; u[15] = a3[3];
            umine = bflo((unsigned)U[(size_t)t * 16 + cmine]); }
        float bur = 0.f, bui = 0.f;
#pragma unroll
        for (int c = 0; c < 16; ++c) { bur += bbr[c] * u[c]; bui += bbi[c] * u[c]; }
        const float nr = lbr * xr - lbi * xi + bur, ni = lbr * xi + lbi * xr + bui; xr = nr; xi = ni;
        if (t < 0) continue;
        float tv[16];
#pragma unroll
        for (int c = 0; c < 16; ++c) tv[c] = cr[c] * xr - ci[c] * xi;
        float v8[8], v4[4], v2[2], v1;
#pragma unroll
        for (int i = 0; i < 8; ++i) { const float keep = b5 ? tv[i + 8] : tv[i], send = b5 ? tv[i] : tv[i + 8]; v8[i] = keep + __shfl_xor(send, 32); }
#pragma unroll
        for (int i = 0; i < 4; ++i) { const float keep = b4 ? v8[i + 4] : v8[i], send = b4 ? v8[i] : v8[i + 4]; v4[i] = keep + __shfl_xor(send, 16); }
#pragma unroll
        for (int i = 0; i < 2; ++i) { const float keep = b3 ? v4[i + 2] : v4[i], send = b3 ? v4[i] : v4[i + 2]; v2[i] = keep + __shfl_xor(send, 8); }
        { const float keep = b2 ? v2[1] : v2[0], send = b2 ? v2[0] : v2[1]; v1 = keep + __shfl_xor(send, 4); }
        v1 += __shfl_xor(v1, 2); v1 += __shfl_xor(v1, 1);
        const float y = gelu_tanh(v1 + dsk * umine);
        if ((lane & 3) == 0) Yb[(size_t)t * SW + cmine] = (bf16)f2bf(y);
    }
}

__device__ __forceinline__ void p6_ln1_router(Frame& F) {
    const int tid_ = fresh_tid(), lane = tid_ & 63, wave = __builtin_amdgcn_readfirstlane(tid_ >> 6);
    const int gw = F.vcu * NWAVES + wave, NGW = F.G * NWAVES;
    const f32x4* gp = (const f32x4*)F.in[I_LN1G] + lane; const f32x4* bp = (const f32x4*)F.in[I_LN1B] + lane;
    const float* MIX = (const float*)(F.ws + WS_MIX); bf16* H1B = (bf16*)(F.ws + WS_H1B); const float* wr = F.in[I_WR];
    const int emine = (lane >> 1) & 31; const float brm = F.in[I_BR][emine];
    const bool b5 = lane & 32, b4 = lane & 16, b3 = lane & 8, b2 = lane & 4, b1 = lane & 2;
    int* list = (int*)(F.ws + WS_LIST); float* wslot = (float*)(F.ws + WS_WSLOT); unsigned* cnt = F.ctl + CW_CNT;
    for (int m = gw; m < M; m += NGW) {
        const f32x4* xr = (const f32x4*)(MIX + (size_t)m * D) + lane;
        float mean, rstd;
        { f32x4 v[4]; float s = 0.f;
#pragma unroll
          for (int j = 0; j < 4; ++j) { v[j] = xr[64 * j]; s += (v[j].x + v[j].y) + (v[j].z + v[j].w); }
          mean = wave_sum(s) * (1.f / D); float s2 = 0.f;
#pragma unroll
          for (int j = 0; j < 4; ++j) { const f32x4 d = v[j] - mean; s2 += (d.x * d.x + d.y * d.y) + (d.z * d.z + d.w * d.w); }
          rstd = 1.f / sqrtf(wave_sum(s2) * (1.f / D) + LN_EPS); }
        float part[32];
#pragma unroll
        for (int e = 0; e < 32; ++e) part[e] = 0.f;
        unsigned long long* o8 = (unsigned long long*)(H1B + (size_t)m * D) + lane;
#pragma unroll 1
        for (int j = 0; j < 4; ++j) { const f32x4 h = (xr[64 * j] - mean) * rstd * gp[64 * j] + bp[64 * j];
            o8[64 * j] = (unsigned long long)pk2(h.x, h.y) | ((unsigned long long)pk2(h.z, h.w) << 32);
            const f32x4* wpj = (const f32x4*)(wr + (size_t)(256 * j + 4 * lane) * NE);
#pragma unroll
            for (int i = 0; i < 4; ++i) { const float hv = h[i]; const f32x4* wp = wpj + i * 8;
#pragma unroll
                for (int q = 0; q < 8; ++q) { const f32x4 w = wp[q]; part[4 * q] += hv * w.x; part[4 * q + 1] += hv * w.y; part[4 * q + 2] += hv * w.z; part[4 * q + 3] += hv * w.w; } } }
        float r16[16], r8[8], r4[4], r2[2], r1;
#pragma unroll
        for (int i = 0; i < 16; ++i) { const float keep = b5 ? part[i + 16] : part[i], send = b5 ? part[i] : part[i + 16]; r16[i] = keep + __shfl_xor(send, 32); }
#pragma unroll
        for (int i = 0; i < 8; ++i) { const float keep = b4 ? r16[i + 8] : r16[i], send = b4 ? r16[i] : r16[i + 8]; r8[i] = keep + __shfl_xor(send, 16); }
#pragma unroll
        for (int i = 0; i < 4; ++i) { const float keep = b3 ? r8[i + 4] : r8[i], send = b3 ? r8[i] : r8[i + 4]; r4[i] = keep + __shfl_xor(send, 8); }
#pragma unroll
        for (int i = 0; i < 2; ++i) { const float keep = b2 ? r4[i + 2] : r4[i], send = b2 ? r4[i] : r4[i + 2]; r2[i] = keep + __shfl_xor(send, 4); }
        { const float keep = b1 ? r2[1] : r2[0], send = b1 ? r2[0] : r2[1]; r1 = keep + __shfl_xor(send, 2); }
        r1 += __shfl_xor(r1, 1);
        float val = r1 + brm;
        float tv[4]; int ti[4];
#pragma unroll
        for (int k = 0; k < 4; ++k) { float bvv = val; int bi = emine;
#pragma unroll
            for (int o = 2; o < 64; o <<= 1) { const float ov = __shfl_xor(bvv, o); const int oi = __shfl_xor(bi, o); if (ov > bvv || (ov == bvv && oi < bi)) { bvv = ov; bi = oi; } }
            tv[k] = bvv; ti[k] = bi; if (emine == bi) val = -INFINITY; }
        const float e1 = __expf(tv[1] - tv[0]), e2 = __expf(tv[2] - tv[0]), e3 = __expf(tv[3] - tv[0]), rs = 1.0f / (1.0f + e1 + e2 + e3);
        if (lane < 4) { const int ek = (lane == 0) ? ti[0] : (lane == 1) ? ti[1] : (lane == 2) ? ti[2] : ti[3]; const float wk = ((lane == 0) ? 1.0f : (lane == 1) ? e1 : (lane == 2) ? e2 : e3) * rs;
            const unsigned pos = __hip_atomic_fetch_add(cnt + ek, 1u, RLX_AGENT);
            list[(size_t)ek * LIST_CAP + pos] = 4 * m + lane; wslot[4 * m + lane] = wk; }
    }
}
__device__ __forceinline__ int moe_tables(Frame& F) {
    LAS int* tab = (LAS int*)(F.lds + TAB_OFF);
    if (fresh_tid() == 0) { int ts = 0; for (int e = 0; e < NE; ++e) { const int c = (int)__hip_atomic_load(F.ctl + CW_CNT + e, RLX_AGENT); tab[e] = ts; tab[40 + e] = c; ts += (c + 255) >> 8; } tab[32] = ts; }
    __syncthreads();
    return tab[32];
}
__device__ __forceinline__ void p9_final(Frame& F) {
    const int tid_ = fresh_tid(), lane = tid_ & 63, wave = __builtin_amdgcn_readfirstlane(tid_ >> 6);
    const int gw = F.vcu * NWAVES + wave, NGW = F.G * NWAVES;
    f32x4 gv[4], bv[4];
#pragma unroll
    for (int j = 0; j < 4; ++j) { gv[j] = *((const f32x4*)F.in[I_LN2G] + lane + 64 * j); bv[j] = *((const f32x4*)F.in[I_LN2B] + lane + 64 * j); }
    const bf16* H1B = (const bf16*)(F.ws + WS_H1B); const bf16* YS = (const bf16*)(F.ws + WS_YS);
    for (int m = gw; m < M; m += NGW) {
        f32x4 v[4]; float s = 0.f;
#pragma unroll
        for (int j = 0; j < 4; ++j) { const u32x2 h = *((const u32x2*)(H1B + (size_t)m * D) + lane + 64 * j); f32x4 a = (f32x4){bflo(h.x), bfhi(h.x), bflo(h.y), bfhi(h.y)} * ALPHA;
#pragma unroll
            for (int k = 0; k < 4; ++k) { const u32x2 y = *((const u32x2*)(YS + (size_t)(4 * m + k) * D) + lane + 64 * j); a = a + (f32x4){bflo(y.x), bfhi(y.x), bflo(y.y), bfhi(y.y)}; }
            v[j] = a; s += (a.x + a.y) + (a.z + a.w); }
        const float mean = wave_sum(s) * (1.f / D); float s2 = 0.f;
#pragma unroll
        for (int j = 0; j < 4; ++j) { v[j] = v[j] - mean; s2 += (v[j].x * v[j].x + v[j].y * v[j].y) + (v[j].z * v[j].z + v[j].w * v[j].w); }
        const float rstd = 1.f / sqrtf(wave_sum(s2) * (1.f / D) + LN_EPS);
        f32x4* op = (f32x4*)(F.out + (size_t)m * D) + lane;
#pragma unroll
        for (int j = 0; j < 4; ++j) op[64 * j] = v[j] * rstd * gv[j] + bv[j];
    }
}

struct Args { const float* in[31]; float* out; unsigned char* ws; int ph_lo, ph_hi, li, pad; };
__global__ void __launch_bounds__(NWAVES * 64, 2) fwd_kernel(Args args) {
    extern __shared__ __attribute__((aligned(16))) unsigned char lds_raw[];
    Frame F;
    F.lds = (LAS unsigned char*)lds_raw; F.MISC = (volatile LAS unsigned*)(F.lds + MISC_OFF);
    F.G = gridDim.x; { const int bx = blockIdx.x; F.vcu = (F.G % 8 == 0) ? (bx % 8) * (F.G / 8) + bx / 8 : bx; }
    F.ws = args.ws; F.ctl = (unsigned*)(args.ws + WS_CTL); F.out = args.out;
#pragma unroll
    for (int i = 0; i < 31; ++i) F.in[i] = args.in[i];
    for (int u = threadIdx.x; u < (LDS_BYTES - LDSCTL_OFF) / 4; u += NWAVES * 64) ((LAS unsigned*)(F.lds + LDSCTL_OFF))[u] = 0u;
    __syncthreads();
    XcdBarrier bar; bar.bar = F.ctl + CW_BAR; bar.x = 0; bar.st = nullptr;
    if (MK_N_LAUNCHES == 1) bar = xcd_barrier_post(F.ctl + CW_BAR, F.MISC + 8);
#define GRID_BAR() do { if (MK_N_LAUNCHES == 1) xcd_barrier(bar); } while (0)
    const int lo = args.ph_lo, hi = args.ph_hi;
#define IN(k) (lo <= (k) && (k) < hi)
#define BOTH(k) (IN(k) && IN((k) + 1))
    using namespace pg8;
    LAS unsigned char* ring = F.lds;

    if (IN(0)) { p0_prologue(F); if (BOTH(0)) GRID_BAR(); }

    if (IN(1)) {
        p1_fcumsum(F);
        DenseSched S; S.init(M, 4096, F.G, (int)blockIdx.x); S.A = (const char*)(F.ws + WS_XN); S.Bt = (const char*)(F.ws + WS_WIN); S.a_tstep = (size_t)BM * D * 2; S.b_tstep = (size_t)BM * D * 2;
        EpiInProj E{(bf16*)(F.ws + WS_Q), (bf16*)(F.ws + WS_K), (bf16*)(F.ws + WS_V), (bf16*)(F.ws + WS_U), (bf16*)(F.ws + WS_GA), (bf16*)(F.ws + WS_GB)};
        gemm_phase<EpiInProj, DenseSched, true, false>(ring, D, D, D, S, E);
        if (BOTH(1)) GRID_BAR();
    }
    if (IN(2)) { p2_attention_naive(F); p2_ssm_seq(F); if (BOTH(2)) GRID_BAR(); }

    if (IN(3)) {
        { DenseSched S; S.init(M, SW, F.G, (int)blockIdx.x); S.A = (const char*)(F.ws + WS_YB); S.Bt = (const char*)(F.ws + WS_WGLU); S.a_tstep = (size_t)BM * SW * 2; S.b_tstep = (size_t)BM * SW * 2;
          EpiGate<0> E{(bf16*)(F.ws + WS_YG), (const bf16*)(F.ws + WS_YB), nullptr, F.in[I_BGLU], SW};
          gemm_phase<EpiGate<0>, DenseSched, true, false>(ring, SW, SW, SW, S, E); }
        { DenseSched S; S.init(M, D, F.G, (int)blockIdx.x); S.A = (const char*)(F.ws + WS_YA); S.Bt = (const char*)(F.ws + WS_WUPA); S.a_tstep = (size_t)BM * AW * 2; S.b_tstep = (size_t)BM * AW * 2;
          EpiGate<1> E{(bf16*)(F.ws + WS_T1), nullptr, (const bf16*)(F.ws + WS_GA), nullptr, D};
          gemm_phase<EpiGate<1>, DenseSched, true, false>(ring, AW, AW, AW, S, E); }
        if (BOTH(3)) GRID_BAR();
    }
    if (IN(4)) {
        DenseSched S; S.init(M, D, F.G, (int)blockIdx.x); S.A = (const char*)(F.ws + WS_YG); S.Bt = (const char*)(F.ws + WS_WUPB); S.a_tstep = (size_t)BM * SW * 2; S.b_tstep = (size_t)BM * SW * 2;
        EpiGate<2> E{(bf16*)(F.ws + WS_MG), (const bf16*)(F.ws + WS_T1), (const bf16*)(F.ws + WS_GB), nullptr, D};
        gemm_phase<EpiGate<2>, DenseSched, true, false>(ring, SW, SW, SW, S, E);
        if (BOTH(4)) GRID_BAR();
    }
    if (IN(5)) {
        DenseSched S; S.init(M, D, F.G, (int)blockIdx.x); S.A = (const char*)(F.ws + WS_MG); S.Bt = (const char*)(F.ws + WS_WO); S.a_tstep = (size_t)BM * D * 2; S.b_tstep = (size_t)BM * D * 2;
        EpiMix E{(float*)(F.ws + WS_MIX), (const bf16*)(F.ws + WS_XN)};
        gemm_phase<EpiMix, DenseSched, true, false>(ring, D, D, D, S, E);
        if (BOTH(5)) GRID_BAR();
    }
    if (IN(6)) { p6_ln1_router(F); if (BOTH(6)) GRID_BAR(); }

    if (IN(7)) {
        const int ntile = moe_tables(F);
        MoeSched S; S.tab = (const LAS int*)(F.lds + TAB_OFF); S.G = F.G; S.c = (int)blockIdx.x; S.npn = 8; S.total = ntile * 8;
        S.A = (const char*)(F.ws + WS_H1B); S.a_tstep = 0; S.Bt = (const char*)(F.ws + WS_WGU); S.b_estep = (size_t)2048 * D * 2; S.b_tstep = (size_t)BM * D * 2; S.list = (const int*)(F.ws + WS_LIST);
        EpiMoe1 E{(bf16*)(F.ws + WS_ACT), F.in[I_BG], F.in[I_BU]};
        gemm_phase<EpiMoe1, MoeSched, true, true>(ring, D, D, D, S, E);
        if (BOTH(7)) GRID_BAR();
    }
    if (IN(8)) {
        const int ntile = moe_tables(F);
        MoeSched S; S.tab = (const LAS int*)(F.lds + TAB_OFF); S.G = F.G; S.c = (int)blockIdx.x; S.npn = 4; S.total = ntile * 4;
        S.A = (const char*)(F.ws + WS_ACT); S.a_tstep = (size_t)BM * D * 2; S.Bt = (const char*)(F.ws + WS_WD); S.b_estep = (size_t)D * D * 2; S.b_tstep = (size_t)BM * D * 2; S.list = (const int*)(F.ws + WS_LIST);
        EpiMoe2 E{(bf16*)(F.ws + WS_YS), F.in[I_BD], (const int*)(F.ws + WS_LIST), (const float*)(F.ws + WS_WSLOT), (const LAS int*)(F.lds + TAB_OFF)};
        gemm_phase<EpiMoe2, MoeSched, true, false>(ring, D, D, D, S, E);
        if (BOTH(8)) GRID_BAR();
    }
    if (IN(9)) { p9_final(F); }
#undef IN
#undef BOTH
#undef GRID_BAR
}

extern "C" void kernel_launch(void* const* d_in, const int* in_sizes, int n_in, void* d_out, int out_size, void* d_ws, size_t ws_size, hipStream_t stream) {
    static int grid = 0;
    if (grid == 0) {
        if (n_in != 31 || in_sizes[0] != M * D || out_size != M * D || ws_size < WS_END) { fprintf(stderr, "kernel_launch: unexpected shapes / workspace (n_in %d, ws %zu, need %zu)\n", n_in, ws_size, (size_t)WS_END); grid = -1; return; }
        int dev = 0, cus = 0, per_cu = 0;
        if (hipGetDevice(&dev) != hipSuccess || hipDeviceGetAttribute(&cus, hipDeviceAttributeMultiprocessorCount, dev) != hipSuccess) { grid = -1; return; }
        if (hipFuncSetAttribute((const void*)fwd_kernel, hipFuncAttributeMaxDynamicSharedMemorySize, LDS_BYTES) != hipSuccess) { fprintf(stderr, "kernel_launch: hipFuncSetAttribute failed\n"); grid = -1; return; }
        if (hipOccupancyMaxActiveBlocksPerMultiprocessor(&per_cu, (const void*)fwd_kernel, NWAVES * 64, LDS_BYTES) != hipSuccess || per_cu < 1) fprintf(stderr, "kernel_launch: occupancy query reports %d\n", per_cu);
        (void)hipGetLastError();
        grid = cus;
        if (grid != 256) { fprintf(stderr, "kernel_launch: built for a 256-CU device, got %d\n", grid); grid = -1; return; }
    }
    if (grid < 0) return;
    if (hipMemsetAsync((char*)d_ws + WS_CTL, 0, CTL_ZERO_BYTES, stream) != hipSuccess) return;
    Args a{};
    for (int i = 0; i < 31; ++i) a.in[i] = (const float*)d_in[i];
    a.out = (float*)d_out; a.ws = (unsigned char*)d_ws; a.pad = 0;
    if (MK_N_LAUNCHES == 1) { a.ph_lo = 0; a.ph_hi = NPHASES; a.li = 0; hipLaunchKernelGGL(fwd_kernel, dim3(grid), dim3(NWAVES * 64), LDS_BYTES, stream, a); }
    else { for (int li = 0; li < NPHASES; ++li) { a.ph_lo = li; a.ph_hi = li + 1; a.li = li; hipLaunchKernelGGL(fwd_kernel, dim3(grid), dim3(NWAVES * 64), LDS_BYTES, stream, a); } }
}
```

```cpp
#include <hip/hip_runtime.h>
#include <cstdio>
#include <cstdint>

#define LAS __attribute__((address_space(3)))
#define GAS __attribute__((address_space(1)))
typedef unsigned short bf16;
typedef short bf16x8 __attribute__((ext_vector_type(8)));
typedef float f32x4 __attribute__((ext_vector_type(4)));
typedef float f32x2 __attribute__((ext_vector_type(2)));
typedef unsigned u32x4 __attribute__((ext_vector_type(4)));
typedef unsigned u32x2 __attribute__((ext_vector_type(2)));
typedef GAS unsigned gu32;

constexpr int NB = 2, SEQ = 8192, M = NB * SEQ, D = 1024, NMETA = 16, NH = 8, HD = 64, AW = 512, SW = 512, NG = 32, GC = 16, NP = 64, NE = 32, TOPK = 4;
constexpr int IN_COLS = 4104, F_OFF = 1536, U_OFF = 1544, GA_OFF = 2056, GB_OFF = 3080;
constexpr float LN_EPS = 1e-5f;
constexpr float ALPHA = 1.189207115002721f;
constexpr float LOG2E = 1.4426950408889634f;
constexpr float QSCALE = 0.125f * LOG2E;
constexpr float SW_LIMIT = 7.0f, SW_ALPHA = 1.702f;
constexpr int LIST_CAP = M;
constexpr int ACT_ROWS = 73728;

constexpr size_t MiB = 1u << 20;
constexpr size_t WS_CTL = 0, CTL_ZERO_BYTES = 1 * MiB;
constexpr size_t WS_WIN = 2 * MiB;
constexpr size_t WS_WUPA = 10 * MiB, WS_WUPB = 11 * MiB, WS_WO = 12 * MiB, WS_WGLU = 14 * MiB;
constexpr size_t WS_SMALL = 15 * MiB;
constexpr size_t WS_LOGF = 16 * MiB;
constexpr size_t WS_F2X = 17 * MiB;
constexpr size_t WS_LIST = 18 * MiB;
constexpr size_t WS_WSLOT = 20 * MiB;
constexpr size_t WS_WGU = 32 * MiB;
constexpr size_t WS_YS = 32 * MiB;
constexpr size_t WS_WD = 160 * MiB;
constexpr size_t WS_XN = 224 * MiB;
constexpr size_t WS_ACT = 224 * MiB;
constexpr size_t WS_Q = 256 * MiB, WS_K = 272 * MiB, WS_V = 288 * MiB;
constexpr size_t WS_U3 = 416 * MiB;
constexpr size_t WS_SS = 440 * MiB;
constexpr size_t WS_WY = 21 * MiB, WS_WSS = 27 * MiB;
constexpr size_t WS_MG = 256 * MiB;
constexpr size_t WS_GA = 320 * MiB, WS_GB = 352 * MiB;
constexpr size_t WS_YA = 384 * MiB, WS_YB = 400 * MiB, WS_YG = 416 * MiB, WS_T1 = 432 * MiB;
constexpr size_t WS_H1B = 368 * MiB;
constexpr size_t WS_MIX = 400 * MiB;
constexpr size_t WS_END = 464 * MiB;
constexpr size_t SM_KMETA = 0, SM_VMETA = 65536, SM_LOGFM = 131072, SM_UMETA = 135168, SM_F2M = 167936;
constexpr int CW_TMO = 0, CW_CODE = 1;
constexpr int CW_CNT = 64;
constexpr int CW_QHEAD = 192;
constexpr int CW_BAR = 4096;

constexpr int RING_BYTES = 131072;
constexpr int LDSCTL_OFF = RING_BYTES, MISC_OFF = LDSCTL_OFF + 320, TAB_OFF = LDSCTL_OFF + 1024;
constexpr int LDS_BYTES = 147456;
constexpr int NWAVES = 8;

#ifndef MK_N_LAUNCHES
#define MK_N_LAUNCHES 1
#endif
constexpr int NPHASES = 10;

#define RLX_AGENT __ATOMIC_RELAXED, __HIP_MEMORY_SCOPE_AGENT
#define LDS_WAIT() asm volatile("s_waitcnt lgkmcnt(0)" ::: "memory")
#define VM_WAIT() asm volatile("s_waitcnt vmcnt(0)" ::: "memory")
__device__ __forceinline__ unsigned f2bf(float f) { unsigned u = __builtin_bit_cast(unsigned, f); return (u + 0x7fffu + ((u >> 16) & 1u)) >> 16; }
__device__ __forceinline__ unsigned pk2(float lo, float hi) { return f2bf(lo) | (f2bf(hi) << 16); }
__device__ __forceinline__ unsigned cvt_pk_bf16(float lo, float hi) { unsigned r; asm volatile("v_cvt_pk_bf16_f32 %0, %1, %2" : "=v"(r) : "v"(lo), "v"(hi)); return r; }
__device__ __forceinline__ float bflo(unsigned u) { return __builtin_bit_cast(float, u << 16); }
__device__ __forceinline__ float bfhi(unsigned u) { return __builtin_bit_cast(float, u & 0xffff0000u); }
__device__ __forceinline__ float sigmoidf_(float x) { return __builtin_amdgcn_rcpf(1.0f + __builtin_amdgcn_exp2f(-x * LOG2E)); }
__device__ __forceinline__ int fresh_tid() { int t = threadIdx.x; asm volatile("" : "+v"(t)); return t; }
__device__ __forceinline__ float wave_sum(float v) {
#pragma unroll
    for (int o = 1; o < 64; o <<= 1) v += __shfl_xor(v, o);
    return v;
}
__device__ __forceinline__ float log_sigmoidf_(float x) { const float y = __expf(-fabsf(x)); return fminf(x, 0.f) - __logf(1.0f + y); }
__device__ __forceinline__ float gelu_tanh(float x) {
    const float z = 0.7978845608028654f * (x + 0.044715f * x * x * x);
    return x * sigmoidf_(2.0f * z);
}
__device__ __forceinline__ void sincos_acc(float x, float& s, float& c) {
    const float kf = rintf(x * 0.6366197723675814f); const int k = (int)kf;
    float r = fmaf(-kf, 1.5703125f, x); r = fmaf(-kf, 4.837512969970703125e-4f, r); r = fmaf(-kf, 7.54978995489188216e-8f, r);
    const float r2 = r * r;
    const float sp = r + r * r2 * (-1.6666654611e-1f + r2 * (8.3321608736e-3f + r2 * (-1.9515295891e-4f)));
    const float cp = 1.0f - 0.5f * r2 + r2 * r2 * (4.166664568298827e-2f + r2 * (-1.388731625493765e-3f + r2 * 2.443315711809948e-5f));
    const int q = k & 3;
    s = (q == 0) ? sp : (q == 1) ? cp : (q == 2) ? -sp : -cp;
    c = (q == 0) ? cp : (q == 1) ? -sp : (q == 2) ? -cp : sp;
}

namespace pg8 {
constexpr int BM = 256, BK = 64, HALF = 128, HTB = HALF * BK * 2, STAGE_BYTES = 8 * HTB, NXCD = 8, WGM = 8;
__host__ __device__ __forceinline__ int lds_byte(int r, int c) { const int st = (r >> 4) * 2 + (c >> 5), rr = r & 15, cc = c & 31, ob = rr * 64 + cc * 2; return st * 1024 + (ob ^ (((ob >> 9) & 1) << 5)); }
__host__ __device__ __forceinline__ void stage_rc(int b, int& R, int& C) { const int st = b / 1024, sb = b % 1024, swz = sb ^ (((sb >> 9) & 1) << 5); R = (st >> 1) * 16 + swz / 64; C = (st & 1) * 32 + (swz % 64) / 2; }
__host__ __device__ __forceinline__ int perm32(int rho) { const int n = rho >> 4, i = rho & 15; return 8 * (i >> 2) + 4 * n + (i & 3); }

struct Unit { int pm, pn, e, mt; };

struct StaticOrder {
    int nM, nN, nwg, G, c;
    __device__ void init(int M_, int N_, int G_, int c_) { nM = M_ / BM; nN = N_ / BM; nwg = nM * nN; G = G_; c = c_; }
    __device__ bool next(int i, Unit& u) const {
        const long L = (long)i * G + c; if (L >= nwg) return false;
        int wgid = (int)L; { const int q = nwg / NXCD, r = nwg % NXCD, xcd = wgid % NXCD, off = wgid / NXCD; wgid = (xcd < r ? xcd * (q + 1) : r * (q + 1) + (xcd - r) * q) + off; }
        const int nig = WGM * nN, gid = wgid / nig, fm = gid * WGM, gsz = (nM - fm) < WGM ? (nM - fm) : WGM;
        u.pm = fm + ((wgid % nig) % gsz); u.pn = (wgid % nig) / gsz; u.e = 0; u.mt = 0; return true;
    }
};
struct DenseSched : StaticOrder {
    const char* A; const char* Bt; size_t a_tstep, b_tstep;
    __device__ __forceinline__ const char* a_base(const Unit& u) const { return A + (size_t)u.pm * a_tstep; }
    __device__ __forceinline__ const char* b_base(const Unit& u) const { return Bt + (size_t)u.pn * b_tstep; }
    __device__ __forceinline__ unsigned a_row_off(const Unit&, int) const { return 0u; }
};

template <class Epi, class Sched, bool ALIGN_EPI, bool GATHER>
__device__ __forceinline__ void gemm_phase(LAS unsigned char* lds, const int K, const int lda, const int ldb, const Sched& S, const Epi& E) {
    const int tid = fresh_tid(), wid = __builtin_amdgcn_readfirstlane(tid >> 6), lane = tid & 63, wr = wid >> 2, wc = wid & 3, fr = lane & 15, fq = lane >> 4;
    const int nt = K / BK;
    unsigned voffA[2][2], nvoffA[2][2], voffB[2]; int RA[2], CA[2];
#pragma unroll
    for (int i = 0; i < 2; ++i) { int R, C; stage_rc(tid * 16 + i * 8192, R, C); const int Rb = Epi::PERM ? ((R & ~31) + perm32(R & 31)) : R;
        RA[i] = R; CA[i] = C; voffB[i] = (unsigned)(Rb * ldb + C) * 2u;
        voffA[0][i] = (unsigned)(R * lda + C) * 2u; voffA[1][i] = (unsigned)((R + HALF) * lda + C) * 2u; nvoffA[0][i] = voffA[0][i]; nvoffA[1][i] = voffA[1][i]; }
    const size_t kstep = (size_t)(BK * 2);
    const size_t hstepB = (size_t)HALF * ldb * 2;
    const unsigned ldsw = (unsigned)wid * 1024u;
    const int aoff = lds_byte(wr * 64 + fr, fq * 8), boff = lds_byte(wc * 32 + fr, fq * 8);
#define PG8_SA(b, h) (((b) * 2 + (h)) * HTB)
#define PG8_SB(b, h) ((4 + (b) * 2 + (h)) * HTB)
#define PG8_STAGE2(bufoff, gbase, v0, v1) do { \
        __builtin_amdgcn_global_load_lds((const unsigned*)((const char*)(gbase) + (v0)), (LAS unsigned*)(lds + (bufoff) + ldsw), 16, 0, 0); \
        __builtin_amdgcn_global_load_lds((const unsigned*)((const char*)(gbase) + (v1)), (LAS unsigned*)(lds + (bufoff) + ldsw + 8192), 16, 0, 0); } while (0)
#define PG8_STAGEB(bufoff, gbase) PG8_STAGE2(bufoff, gbase, voffB[0], voffB[1])
#define PG8_LDA(dst, b, h) do { _Pragma("unroll") for (int m = 0; m < 4; ++m) _Pragma("unroll") for (int k = 0; k < 2; ++k) dst[m][k] = *(const LAS bf16x8*)(lds + PG8_SA(b, h) + aoff + m * 2048 + k * 1024); } while (0)
#define PG8_LDB(dst, b, h) do { _Pragma("unroll") for (int n = 0; n < 2; ++n) _Pragma("unroll") for (int k = 0; k < 2; ++k) dst[n][k] = *(const LAS bf16x8*)(lds + PG8_SB(b, h) + boff + n * 2048 + k * 1024); } while (0)
#define PG8_MMA(ai, bj, At, Bt) do { __builtin_amdgcn_s_setprio(1); _Pragma("unroll") for (int m = 0; m < 4; ++m) _Pragma("unroll") for (int n = 0; n < 2; ++n) _Pragma("unroll") for (int k = 0; k < 2; ++k) \
        acc[ai][bj][m][n] = __builtin_amdgcn_mfma_f32_16x16x32_bf16(Bt[n][k], At[m][k], acc[ai][bj][m][n], 0, 0, 0); __builtin_amdgcn_s_setprio(0); } while (0)
#define PG8_WAIT_V(n) asm volatile("s_waitcnt vmcnt(" #n ")" ::: "memory")
#define PG8_WAIT_L(n) asm volatile("s_waitcnt lgkmcnt(" #n ")" ::: "memory")
#define PG8_BAR __builtin_amdgcn_s_barrier()
#define PG8_SCHED __builtin_amdgcn_sched_barrier(0)
    Unit cur, nxt; int ui = 0;
    if (!S.next(0, cur)) return;
    f32x4 acc[2][2][4][2];
#pragma unroll
    for (int a = 0; a < 2; ++a)
#pragma unroll
        for (int b = 0; b < 2; ++b)
#pragma unroll
            for (int m = 0; m < 4; ++m)
#pragma unroll
                for (int n = 0; n < 2; ++n) acc[a][b][m][n] = (f32x4){0.f, 0.f, 0.f, 0.f};
    bf16x8 At[4][2], B0[2][2], B1[2][2];
    const char* cA = S.a_base(cur); const char* cB = S.b_base(cur);
    if constexpr (GATHER) {
#pragma unroll
        for (int h = 0; h < 2; ++h)
#pragma unroll
            for (int i = 0; i < 2; ++i) voffA[h][i] = S.a_row_off(cur, h * HALF + RA[i]) + (unsigned)CA[i] * 2u;
        PG8_WAIT_V(0);
    }
    PG8_STAGEB(PG8_SB(0, 0), cB); PG8_STAGEB(PG8_SB(0, 1), cB + hstepB); PG8_STAGE2(PG8_SA(0, 0), cA, voffA[0][0], voffA[0][1]); PG8_STAGE2(PG8_SA(0, 1), cA, voffA[1][0], voffA[1][1]);
    if (wr == 1) PG8_BAR;
    PG8_WAIT_V(2); PG8_BAR;
    PG8_STAGEB(PG8_SB(1, 0), cB + kstep); PG8_STAGE2(PG8_SA(1, 0), cA + kstep, voffA[0][0], voffA[0][1]); PG8_STAGEB(PG8_SB(1, 1), cB + hstepB + kstep);
    PG8_WAIT_V(6); PG8_BAR;
    for (;;) {
        const bool has_next = S.next(ui + 1, nxt);
        const char* nA = has_next ? S.a_base(nxt) : cA; const char* nB = has_next ? S.b_base(nxt) : cB;
        if constexpr (GATHER) {
            if (has_next) {
#pragma unroll
                for (int h = 0; h < 2; ++h)
#pragma unroll
                    for (int i = 0; i < 2; ++i) nvoffA[h][i] = S.a_row_off(nxt, h * HALF + RA[i]) + (unsigned)CA[i] * 2u;
                PG8_WAIT_V(0);
            } else {
#pragma unroll
                for (int h = 0; h < 2; ++h)
#pragma unroll
                    for (int i = 0; i < 2; ++i) nvoffA[h][i] = voffA[h][i];
            }
        }
        for (int t = 0; t < nt; t += 2) {
            const bool last = (t == nt - 2);
            const char* a1 = cA + (size_t)(t + 1) * kstep;
            const char* a2 = last ? nA : cA + (size_t)(t + 2) * kstep; const char* b2 = last ? nB : cB + (size_t)(t + 2) * kstep;
            const char* a3 = a2 + kstep; const char* b3 = b2 + kstep;
            unsigned w00, w01, w10, w11;
            if constexpr (GATHER) { w00 = last ? nvoffA[0][0] : voffA[0][0]; w01 = last ? nvoffA[0][1] : voffA[0][1]; w10 = last ? nvoffA[1][0] : voffA[1][0]; w11 = last ? nvoffA[1][1] : voffA[1][1]; }
            else { w00 = voffA[0][0]; w01 = voffA[0][1]; w10 = voffA[1][0]; w11 = voffA[1][1]; }
            PG8_LDB(B0, 0, 0); PG8_LDB(B1, 0, 1); PG8_SCHED; PG8_LDA(At, 0, 0); PG8_STAGE2(PG8_SA(1, 1), a1, voffA[1][0], voffA[1][1]);
            PG8_WAIT_V(8); PG8_WAIT_L(0); PG8_BAR; PG8_MMA(0, 0, At, B0); PG8_MMA(0, 1, At, B1); PG8_BAR; PG8_SCHED;
            PG8_LDA(At, 0, 1); PG8_STAGEB(PG8_SB(0, 0), b2); PG8_STAGEB(PG8_SB(0, 1), b2 + hstepB); PG8_STAGE2(PG8_SA(0, 0), a2, w00, w01);
            PG8_WAIT_V(8); PG8_WAIT_L(0); PG8_BAR; PG8_MMA(1, 0, At, B0); PG8_MMA(1, 1, At, B1); PG8_BAR; PG8_SCHED;
            PG8_LDB(B0, 1, 0); PG8_LDB(B1, 1, 1); PG8_SCHED; PG8_LDA(At, 1, 0); PG8_STAGE2(PG8_SA(0, 1), a2, w10, w11);
            PG8_WAIT_V(8); PG8_WAIT_L(0); PG8_BAR; PG8_MMA(0, 0, At, B0); PG8_MMA(0, 1, At, B1); PG8_BAR; PG8_SCHED;
            PG8_LDA(At, 1, 1); PG8_STAGEB(PG8_SB(1, 0), b3); PG8_STAGEB(PG8_SB(1, 1), b3 + hstepB); PG8_STAGE2(PG8_SA(1, 0), a3, w00, w01);
            PG8_WAIT_V(8); PG8_WAIT_L(0); PG8_BAR; PG8_MMA(1, 0, At, B0); PG8_MMA(1, 1, At, B1); PG8_BAR; PG8_SCHED;
        }
        if constexpr (ALIGN_EPI) { if (wr == 0) PG8_BAR; }
        E(acc, cur, wr, wc, fr, fq);
        if (!has_next) break;
#pragma unroll
        for (int a = 0; a < 2; ++a)
#pragma unroll
            for (int b = 0; b < 2; ++b)
#pragma unroll
                for (int m = 0; m < 4; ++m)
#pragma unroll
                    for (int n = 0; n < 2; ++n) acc[a][b][m][n] = (f32x4){0.f, 0.f, 0.f, 0.f};
        cur = nxt; cA = nA; cB = nB; ++ui;
        if constexpr (GATHER) {
#pragma unroll
            for (int h = 0; h < 2; ++h)
#pragma unroll
                for (int i = 0; i < 2; ++i) voffA[h][i] = nvoffA[h][i];
        }
        if constexpr (ALIGN_EPI) { if (wr == 1) PG8_BAR; }
    }
    PG8_WAIT_V(0);
    if constexpr (!ALIGN_EPI) { if (wr == 0) PG8_BAR; }
    PG8_BAR;
#undef PG8_SA
#undef PG8_SB
#undef PG8_STAGE2
#undef PG8_STAGEB
#undef PG8_LDA
#undef PG8_LDB
#undef PG8_MMA
#undef PG8_WAIT_V
#undef PG8_WAIT_L
#undef PG8_BAR
#undef PG8_SCHED
}

typedef f32x4 Acc[2][2][4][2];
__device__ __forceinline__ u32x4 pack8(f32x4 v0, f32x4 v1) { u32x4 w; w.x = cvt_pk_bf16(v0[0], v0[1]); w.y = cvt_pk_bf16(v0[2], v0[3]); w.z = cvt_pk_bf16(v1[0], v1[1]); w.w = cvt_pk_bf16(v1[2], v1[3]); return w; }
__device__ __forceinline__ void unpack8(u32x4 w, f32x4& v0, f32x4& v1) { v0 = (f32x4){bflo(w.x), bfhi(w.x), bflo(w.y), bfhi(w.y)}; v1 = (f32x4){bflo(w.z), bfhi(w.z), bflo(w.w), bfhi(w.w)}; }
__device__ __forceinline__ f32x4 sig4(f32x4 v) { return (f32x4){sigmoidf_(v[0]), sigmoidf_(v[1]), sigmoidf_(v[2]), sigmoidf_(v[3])}; }

struct EpiInProj {
    static constexpr bool PERM = true;
    bf16 *Q, *Kk, *V, *U, *GA, *GB;
    __device__ __forceinline__ void operator()(const Acc& acc, const Unit& u, int wr, int wc, int fr, int fq) const {
        const int pn = u.pn, row0 = u.pm * BM + wr * 64 + fr, ct = wc * 32 + 8 * fq;
        bf16* base; int ldc, colb, mode;
        if (pn < 2) { base = Q; ldc = AW; colb = pn * 256; mode = 1; }
        else if (pn < 4) { base = Kk; ldc = AW; colb = (pn - 2) * 256; mode = 0; }
        else if (pn < 6) { base = V; ldc = AW; colb = (pn - 4) * 256; mode = 0; }
        else if (pn < 8) { base = U; ldc = 0; colb = (pn - 6) * 256; mode = 3; }
        else if (pn < 12) { base = GA; ldc = D; colb = (pn - 8) * 256; mode = 2; }
        else { base = GB; ldc = D; colb = (pn - 12) * 256; mode = 2; }
#pragma unroll
        for (int ai = 0; ai < 2; ++ai)
#pragma unroll
            for (int m = 0; m < 4; ++m) { const int row = row0 + ai * HALF + m * 16;
#pragma unroll
                for (int bj = 0; bj < 2; ++bj) { f32x4 v0 = acc[ai][bj][m][0], v1 = acc[ai][bj][m][1]; const int col = colb + bj * HALF + ct;
                    if (mode == 1) { v0 = v0 * QSCALE; v1 = v1 * QSCALE; }
                    if (mode == 2) { v0 = sig4(v0); v1 = sig4(v1); }
                    bf16* p = (mode == 3) ? base + ((size_t)(col >> 4) * 1024 + (row >> 4)) * 384 + (row & 15) * 16 + (col & 15) : base + (size_t)row * ldc + col;
                    *(u32x4*)p = pack8(v0, v1); } }
    }
};
template <int MODE> struct EpiGate {
    static constexpr bool PERM = true;
    bf16* O; const bf16* X; const bf16* G; const float* bias; int ldc;
    __device__ __forceinline__ void operator()(const Acc& acc, const Unit& u, int wr, int wc, int fr, int fq) const {
        const int row0 = u.pm * BM + wr * 64 + fr, col0 = u.pn * BM + wc * 32 + 8 * fq;
#pragma unroll
        for (int ai = 0; ai < 2; ++ai)
#pragma unroll
            for (int m = 0; m < 4; ++m) { const size_t ro = (size_t)(row0 + ai * HALF + m * 16) * ldc;
#pragma unroll
                for (int bj = 0; bj < 2; ++bj) { f32x4 v0 = acc[ai][bj][m][0], v1 = acc[ai][bj][m][1]; const int col = col0 + bj * HALF; f32x4 x0, x1, g0, g1;
                    if (MODE == 0) { const f32x4 b0 = *(const f32x4*)(bias + col), b1 = *(const f32x4*)(bias + col + 4); unpack8(*(const u32x4*)(X + ro + col), x0, x1); v0 = x0 * sig4(v0 + b0); v1 = x1 * sig4(v1 + b1); }
                    if (MODE == 1) { unpack8(*(const u32x4*)(G + ro + col), g0, g1); v0 = v0 * g0; v1 = v1 * g1; }
                    if (MODE == 2) { unpack8(*(const u32x4*)(G + ro + col), g0, g1); unpack8(*(const u32x4*)(X + ro + col), x0, x1); v0 = x0 + v0 * g0; v1 = x1 + v1 * g1; }
                    *(u32x4*)(O + ro + col) = pack8(v0, v1); } }
    }
};
struct EpiMix {
    static constexpr bool PERM = false;
    float* O; const bf16* XN;
    __device__ __forceinline__ void operator()(const Acc& acc, const Unit& u, int wr, int wc, int fr, int fq) const {
        const int row0 = u.pm * BM + wr * 64 + fr, col0 = u.pn * BM + wc * 32 + 4 * fq;
#pragma unroll
        for (int ai = 0; ai < 2; ++ai)
#pragma unroll
            for (int m = 0; m < 4; ++m) { const size_t ro = (size_t)(row0 + ai * HALF + m * 16) * D;
#pragma unroll
                for (int bj = 0; bj < 2; ++bj)
#pragma unroll
                    for (int n = 0; n < 2; ++n) { const int col = col0 + bj * HALF + n * 16; const u32x2 h = *(const u32x2*)(XN + ro + col);
                        const f32x4 hv = (f32x4){bflo(h.x), bfhi(h.x), bflo(h.y), bfhi(h.y)};
                        *(f32x4*)(O + ro + col) = hv * ALPHA + acc[ai][bj][m][n]; } }
    }
};
struct EpiMoe1 {
    static constexpr bool PERM = true;
    bf16* ACT; const float* bg; const float* bu;
    __device__ __forceinline__ void operator()(const Acc& acc, const Unit& u, int wr, int wc, int fr, int fq) const {
        const int row0 = u.pm * BM + wr * 64 + fr, col = u.pn * HALF + wc * 32 + 8 * fq;
        const float* pg = bg + (size_t)u.e * D + col; const float* pu = bu + (size_t)u.e * D + col;
        const f32x4 g0 = *(const f32x4*)pg, g1 = *(const f32x4*)(pg + 4), u0 = *(const f32x4*)pu, u1 = *(const f32x4*)(pu + 4);
#pragma unroll
        for (int ai = 0; ai < 2; ++ai)
#pragma unroll
            for (int m = 0; m < 4; ++m) { const size_t ro = (size_t)(row0 + ai * HALF + m * 16) * D;
                f32x4 ga = acc[ai][0][m][0] + g0, gb = acc[ai][0][m][1] + g1, ua = acc[ai][1][m][0] + u0, ub = acc[ai][1][m][1] + u1;
#pragma unroll
                for (int i = 0; i < 4; ++i) { const float g_ = fminf(ga[i], SW_LIMIT), u_ = fminf(fmaxf(ua[i], -SW_LIMIT), SW_LIMIT); ga[i] = (u_ + 1.0f) * g_ * sigmoidf_(SW_ALPHA * g_);
                    const float g2 = fminf(gb[i], SW_LIMIT), u2 = fminf(fmaxf(ub[i], -SW_LIMIT), SW_LIMIT); gb[i] = (u2 + 1.0f) * g2 * sigmoidf_(SW_ALPHA * g2); }
                *(u32x4*)(ACT + ro + col) = pack8(ga, gb); }
    }
};
struct EpiMoe2 {
    static constexpr bool PERM = true;
    bf16* YS; const float* bd; const int* list; const float* wslot; const LAS int* tab;
    __device__ __forceinline__ void operator()(const Acc& acc, const Unit& u, int wr, int wc, int fr, int fq) const {
        const int r0 = wr * 64 + fr, col0 = u.pn * BM + wc * 32 + 8 * fq, cnt = tab[40 + u.e];
        const float* pb = bd + (size_t)u.e * D + col0;
        f32x4 b[2][2];
#pragma unroll
        for (int bj = 0; bj < 2; ++bj) { b[bj][0] = *(const f32x4*)(pb + bj * HALF); b[bj][1] = *(const f32x4*)(pb + bj * HALF + 4); }
#pragma unroll
        for (int ai = 0; ai < 2; ++ai)
#pragma unroll
            for (int m = 0; m < 4; ++m) { const int rr = u.mt * BM + r0 + ai * HALF + m * 16;
                if (rr < cnt) { const int slot = list[(size_t)u.e * LIST_CAP + rr]; const float w = wslot[slot];
#pragma unroll
                    for (int bj = 0; bj < 2; ++bj) { const f32x4 v0 = (acc[ai][bj][m][0] + b[bj][0]) * w, v1 = (acc[ai][bj][m][1] + b[bj][1]) * w;
                        *(u32x4*)(YS + (size_t)slot * D + col0 + bj * HALF) = pack8(v0, v1); } } }
    }
};
struct MoeSched {
    const LAS int* tab; int G, c, npn, total;
    const char* A; const char* Bt; size_t a_tstep, b_estep, b_tstep; const int* list;
    __device__ __forceinline__ bool next(int i, Unit& u) const {
        const int L = i * G + c; if (L >= total) return false;
        const int tau = L / npn; u.pn = L - tau * npn; int e = 0;
        for (int j = 1; j < NE; ++j) if (tab[j] <= tau) e = j;
        u.e = e; u.pm = tau; u.mt = tau - tab[e]; return true;
    }
    __device__ __forceinline__ const char* a_base(const Unit& u) const { return A + (size_t)u.pm * a_tstep; }
    __device__ __forceinline__ const char* b_base(const Unit& u) const { return Bt + (size_t)u.e * b_estep + (size_t)u.pn * b_tstep; }
    __device__ __forceinline__ unsigned a_row_off(const Unit& u, int r) const {
        const int rr = u.mt * BM + r; const int cnt = tab[40 + u.e]; int tok = 0;
        if (rr < cnt) tok = list[(size_t)u.e * LIST_CAP + rr] >> 2;
        return (unsigned)tok * (unsigned)(D * 2);
    }
};
struct SsmSched { const char* A; const char* Bt; size_t a_tstep; int pm0, g;
    __device__ __forceinline__ bool next(int i, Unit& u) const { if (i >= 2) return false; u.pm = pm0 + i; u.pn = 0; u.e = g; u.mt = 0; return true; }
    __device__ __forceinline__ const char* a_base(const Unit& u) const { return A + (size_t)u.pm * a_tstep; }
    __device__ __forceinline__ const char* b_base(const Unit&) const { return Bt; }
    __device__ __forceinline__ unsigned a_row_off(const Unit&, int) const { return 0u; }
};
struct EpiS {
    static constexpr bool PERM = false;
    float* SS;
    __device__ __forceinline__ void operator()(const Acc& acc, const Unit& u, int wr, int wc, int fr, int fq) const {
        const int row0 = u.pm * BM + wr * 64 + fr, col0 = wc * 32 + 4 * fq;
#pragma unroll
        for (int ai = 0; ai < 2; ++ai)
#pragma unroll
            for (int m = 0; m < 4; ++m) { float* rp = SS + ((size_t)u.e * 1024 + row0 + ai * HALF + m * 16) * 128 + col0;
#pragma unroll
                for (int n = 0; n < 2; ++n) *(f32x4*)(rp + n * 16) = acc[ai][0][m][n]; }
    }
};
struct EpiY {
    static constexpr bool PERM = true;
    bf16* Yb;
    __device__ __forceinline__ void operator()(const Acc& acc, const Unit& u, int wr, int wc, int fr, int fq) const {
        const int row0 = u.pm * BM + wr * 64 + fr;
#pragma unroll
        for (int ai = 0; ai < 2; ++ai)
#pragma unroll
            for (int m = 0; m < 4; ++m) { const int r = row0 + ai * HALF + m * 16;
#pragma unroll
                for (int bj = 0; bj < 2; ++bj) { const int n0 = bj * HALF + wc * 32 + 8 * fq, jp = n0 >> 4, c0 = n0 & 15; f32x4 v0 = acc[ai][bj][m][0], v1 = acc[ai][bj][m][1];
#pragma unroll
                    for (int i = 0; i < 4; ++i) { v0[i] = gelu_tanh(v0[i]); v1[i] = gelu_tanh(v1[i]); }
                    *(u32x4*)(Yb + ((size_t)r * 16 + jp) * SW + u.e * GC + c0) = pack8(v0, v1); } }
    }
};
}

#include <hip/hip_bf16.h>
#include <cmath>
namespace attn_body {
using bf16=__hip_bfloat16;
typedef float f32x4_t __attribute__((ext_vector_type(4)));
using bf16x8=__attribute__((ext_vector_type(8)))short;
using s16x4=__attribute__((ext_vector_type(4)))short;
using f32x16=__attribute__((ext_vector_type(16)))float;
using u32x4=__attribute__((ext_vector_type(4)))unsigned;
constexpr int BATCH=2,NHEAD=8,SEQ=8192,D=64,DM=NHEAD*D;
constexpr int NW=8,QBLK=32,QB=QBLK*NW,KVBLK=64,NQB=SEQ/QB;
constexpr int ATTN_PITCH=DM, ATTN_UNIT_ROWS=QB;
__device__ __forceinline__ int crow(int r,int hi){return (r&3)+8*(r>>2)+4*hi;}
#define SBAR() __builtin_amdgcn_sched_barrier(0)
__device__ __forceinline__ void cmask(f32x16&p0,f32x16&p1,int jb,int qrel,int hi){
  const float NEG=-INFINITY; int kb=64*jb+4*hi;
  #pragma unroll
  for(int r=0;r<16;++r){int kv=kb+(r&3)+8*(r>>2); if(kv>qrel)p0[r]=NEG; if(kv+32>qrel)p1[r]=NEG;}
}

constexpr int NSLOT=3, SLOTB=8192;
constexpr int LDS_K=0, LDS_V=NSLOT*SLOTB, LDS_WS=2*NSLOT*SLOTB, LDS_OST=LDS_WS+NW*64*4, LDS_F=LDS_OST+NW*4096, LDS_BYTES=LDS_F+NSLOT*256;
constexpr float C2=0.125f*1.4426950408889634f;
__device__ __forceinline__ void glds16(const void*gsrc,unsigned lds_dst){unsigned keep;
  asm volatile("s_mov_b32 %0, m0\n\ts_mov_b32 m0, %2\n\ts_nop 0\n\tglobal_load_lds_dwordx4 %1, off\n\ts_mov_b32 m0, %0":"=&s"(keep):"v"(gsrc),"s"(lds_dst):"memory");}
__device__ __forceinline__ void glds4(const void*gsrc,unsigned lds_dst){unsigned keep;
  asm volatile("s_mov_b32 %0, m0\n\ts_mov_b32 m0, %2\n\ts_nop 0\n\tglobal_load_lds_dword %1, off\n\ts_mov_b32 m0, %0":"=&s"(keep):"v"(gsrc),"s"(lds_dst):"memory");}
__device__ __forceinline__ float max3f(float a,float b,float c){float r;asm("v_max3_f32 %0, %1, %2, %3":"=v"(r):"v"(a),"v"(b),"v"(c));return r;}
__device__ __forceinline__ float max2f(float a,float b){float r;asm("v_max_f32_e32 %0, %1, %2":"=v"(r):"v"(a),"v"(b));return r;}
__device__ __forceinline__ float fadd_s(float a,float b){float r;asm("v_add_f32_e32 %0, %1, %2":"=v"(r):"v"(a),"v"(b));return r;}
__device__ __forceinline__ float fsub_s(float a,float b){float r;asm("v_sub_f32_e32 %0, %1, %2":"=v"(r):"v"(a),"v"(b));return r;}
typedef float f32x2_t __attribute__((ext_vector_type(2))); typedef __bf16 bf16x2_t __attribute__((ext_vector_type(2)));
__device__ __forceinline__ unsigned cvtpk_s(float lo,float hi){f32x2_t v={lo,hi};bf16x2_t b=__builtin_convertvector(v,bf16x2_t);return __builtin_bit_cast(unsigned,b);}
#define WAIT_BAR(N) asm volatile("s_waitcnt vmcnt(" #N ") lgkmcnt(0)\n\ts_barrier":::"memory")

__device__ __forceinline__ void qkt(f32x16&p0,f32x16&p1,const char*Kslot,const bf16x8*qr,int r32,int hi){
  const char*kb=Kslot+hi*1024+r32*16;
  #pragma unroll
  for(int d0=0;d0<4;++d0){
    const bf16x8 b0=*reinterpret_cast<const bf16x8*>(kb+d0*2048);
    const bf16x8 b1=*reinterpret_cast<const bf16x8*>(kb+d0*2048+512);
    p0=__builtin_amdgcn_mfma_f32_32x32x16_bf16(b0,qr[d0],p0,0,0,0);p1=__builtin_amdgcn_mfma_f32_32x32x16_bf16(b1,qr[d0],p1,0,0,0);}
}
typedef __attribute__((address_space(3))) const char* lds_cptr;
typedef short v4i16_t __attribute__((ext_vector_type(4)));
__device__ __forceinline__ void kload8(bf16x8*kf,lds_cptr kp){
  kf[0]=*(const __attribute__((address_space(3))) bf16x8*)(kp);      kf[1]=*(const __attribute__((address_space(3))) bf16x8*)(kp+512);
  kf[2]=*(const __attribute__((address_space(3))) bf16x8*)(kp+2048); kf[3]=*(const __attribute__((address_space(3))) bf16x8*)(kp+2560);
  kf[4]=*(const __attribute__((address_space(3))) bf16x8*)(kp+4096); kf[5]=*(const __attribute__((address_space(3))) bf16x8*)(kp+4608);
  kf[6]=*(const __attribute__((address_space(3))) bf16x8*)(kp+6144); kf[7]=*(const __attribute__((address_space(3))) bf16x8*)(kp+6656);
}
__device__ __forceinline__ void kload2(bf16x8*kf,lds_cptr kp,int j){ kf[2*j]=*(const __attribute__((address_space(3))) bf16x8*)(kp+j*2048); kf[2*j+1]=*(const __attribute__((address_space(3))) bf16x8*)(kp+j*2048+512); }
__device__ __forceinline__ s16x4 vtr(lds_cptr p){ return __builtin_bit_cast(s16x4,__builtin_amdgcn_ds_read_tr16_b64_v4i16((__attribute__((address_space(3))) v4i16_t*)p)); }
__device__ __forceinline__ float rowmax(const f32x16&p0,const f32x16&p1){
  float a=max3f(p0[0],p0[1],p1[0]),b=max3f(p0[2],p0[3],p1[1]);a=max3f(a,p1[2],p1[3]);
  #pragma unroll
  for(int r=4;r<16;r+=4){a=max3f(a,p0[r],p0[r+1]);b=max3f(b,p0[r+2],p0[r+3]);a=max3f(a,p1[r],p1[r+1]);b=max3f(b,p1[r+2],p1[r+3]);}
  const float m=max2f(a,b);
  auto rr=__builtin_amdgcn_permlane32_swap(__float_as_uint(m),__float_as_uint(m),false,false);
  return max2f(__uint_as_float(rr[0]),__uint_as_float(rr[1]));
}
__device__ __forceinline__ void pv(f32x16*o,int vb,bf16x8 pa0,bf16x8 pa1,bf16x8 pa2,bf16x8 pa3){
  #pragma unroll
  for(int d0=0;d0<2;++d0){s16x4 lo[4],hi[4];
    #pragma unroll
    for(int ks=0;ks<4;++ks){
      asm volatile("ds_read_b64_tr_b16 %0,%1 offset:%c2":"=&v"(lo[ks]):"v"(vb),"i"(d0*4096+ks*1024):"memory");
      asm volatile("ds_read_b64_tr_b16 %0,%1 offset:%c2":"=&v"(hi[ks]):"v"(vb),"i"(d0*4096+ks*1024+512):"memory");}
    asm volatile("s_waitcnt lgkmcnt(0)":::"memory");SBAR();
    #define PK(k) (bf16x8){lo[k][0],lo[k][1],lo[k][2],lo[k][3],hi[k][0],hi[k][1],hi[k][2],hi[k][3]}
    o[d0]=__builtin_amdgcn_mfma_f32_32x32x16_bf16(pa0,PK(0),o[d0],0,0,0);
    o[d0]=__builtin_amdgcn_mfma_f32_32x32x16_bf16(pa1,PK(1),o[d0],0,0,0);
    o[d0]=__builtin_amdgcn_mfma_f32_32x32x16_bf16(pa2,PK(2),o[d0],0,0,0);
    o[d0]=__builtin_amdgcn_mfma_f32_32x32x16_bf16(pa3,PK(3),o[d0],0,0,0);
    #undef PK
  }
}

#ifndef ATTN_STORE16
#define ATTN_STORE16(p,v) (*(u32x4*)(p)=(v))
#endif
template<int THRL> __device__ __forceinline__ void attn_unit(int b,int h,int qb,const bf16*Q,const bf16*__restrict__ K,const bf16*__restrict__ V,const bf16*__restrict__ KM,const bf16*__restrict__ VM,const float*__restrict__ F2x,const float*__restrict__ F2m,bf16*O,char*shm){
  const int tid=threadIdx.x,lane=tid&63,r32=lane&31,hi=lane>>5; const int wid=__builtin_amdgcn_readfirstlane(tid>>6);
  const long rowbase=(long)b*SEQ; const int q0=qb*QB;
  const bf16*Qw=Q+(rowbase+q0+wid*QBLK)*DM+h*D;
  const bf16*Kh=K+rowbase*DM+h*D,*Vh=V+rowbase*DM+h*D;
  const unsigned lds0=(unsigned)(uintptr_t)shm;
  float*wsf=(float*)(shm+LDS_WS)+wid*64;
  const float*Fh=F2x+(long)(b*NHEAD+h)*SEQ;
  const bf16*ksrc=Kh+(long)lane*DM+wid*8-(long)KVBLK*DM;
  const bf16*vsrc=Vh+(long)(16*(wid&3)+(lane>>2))*DM+(wid>>2)*32+(lane&3)*8-(long)KVBLK*DM;
  const float*fsrc=Fh+lane-KVBLK;
  const bf16*ksrcm=KM+(long)lane*DM+h*D+wid*8;
  const bf16*vsrcm=VM+(long)(16*(wid&3)+(lane>>2))*DM+h*D+(wid>>2)*32+(lane&3)*8;
  const float*fsrcm=F2m+h*64+lane;
  const unsigned kdst=lds0+LDS_K+wid*1024, vdst=lds0+LDS_V+wid*1024, fdst=lds0+LDS_F;
  #define DMA_K(t,slot) glds16(ksrc+(long)(t)*KVBLK*DM,(unsigned)__builtin_amdgcn_readfirstlane(kdst+(slot)))
  #define DMA_V(t,slot) glds16(vsrc+(long)(t)*KVBLK*DM,(unsigned)__builtin_amdgcn_readfirstlane(vdst+(slot)))
  #define DMA_F(t,slot) glds4(fsrc+(long)(t)*KVBLK,(unsigned)__builtin_amdgcn_readfirstlane(fdst+((slot)>>5)))
  #define DMA_KM(slot) glds16(ksrcm,(unsigned)__builtin_amdgcn_readfirstlane(kdst+(slot)))
  #define DMA_VM(slot) glds16(vsrcm,(unsigned)__builtin_amdgcn_readfirstlane(vdst+(slot)))
  #define DMA_FM(slot) glds4(fsrcm,(unsigned)__builtin_amdgcn_readfirstlane(fdst+((slot)>>5)))
  const int vb0=(int)(lds0+LDS_V)+((lane>>4)&1)*32+(lane&3)*8+(4*hi+((lane&15)>>2))*64;
  const char*Kbase=shm+LDS_K; bf16x8 kf[8];
  const lds_cptr kp0=((lds_cptr)shm)+LDS_K+hi*1024+r32*16; const lds_cptr vp0=((lds_cptr)shm)+LDS_V+((lane>>4)&1)*32+(lane&3)*8+(4*hi+((lane&15)>>2))*64;
  const int NT=(q0+QB)/KVBLK+1;
  DMA_KM(0);DMA_FM(0);DMA_VM(0);DMA_K(1,SLOTB);DMA_F(1,SLOTB);
  bf16x8 qr[4];
  #pragma unroll
  for(int d0=0;d0<4;++d0)qr[d0]=*reinterpret_cast<const bf16x8*>(&Qw[(long)r32*DM+d0*16+hi*8]);
  float fqm=Fh[q0+wid*QBLK+r32];
  float l_reg=0.f;f32x16 o[2];o[0]=f32x16{};o[1]=f32x16{};
  const int qrel=wid*QBLK+r32;
  typedef __attribute__((address_space(3))) const f32x4_t* lds_f4ptr;
  #define CIN(P0,P1,fso) do{ const lds_f4ptr fp_=(lds_f4ptr)(shm3+LDS_F+(fso)+hi*16); \
    _Pragma("unroll") for(int g_=0;g_<4;++g_){ const f32x4_t a_=fp_[2*g_], b_=fp_[8+2*g_]; \
      P0[4*g_]=fqm-a_[0];P0[4*g_+1]=fqm-a_[1];P0[4*g_+2]=fqm-a_[2];P0[4*g_+3]=fqm-a_[3]; \
      P1[4*g_]=fqm-b_[0];P1[4*g_+1]=fqm-b_[1];P1[4*g_+2]=fqm-b_[2];P1[4*g_+3]=fqm-b_[3]; } }while(0)
  #define CMASK(P0,P1,t) do{int jb_=(t)-(NT-4); if(jb_>=0)cmask(P0,P1,jb_,qrel,hi);}while(0)
  bool resc=false;
  #define START(P0,P1) do{ const float rm=rowmax(P0,P1); resc=false; \
    if(__any(rm>(float)THRL)){ const float dl=__builtin_fmaxf(rm,0.f); fqm-=dl; \
      _Pragma("unroll") for(int r=0;r<16;++r){P0[r]=fsub_s(P0[r],dl);P1[r]=fsub_s(P1[r],dl);} } \
    _Pragma("unroll") for(int r=0;r<16;++r)P0[r]=__builtin_amdgcn_exp2f(P0[r]); }while(0)
  #define RESC() do{ if(resc){ asm volatile("s_waitcnt lgkmcnt(0)":::"memory"); \
      _Pragma("unroll") for(int d_=0;d_<2;++d_) _Pragma("unroll") for(int r=0;r<16;++r)o[d_][r]*=wsf[crow(r,hi)]; } }while(0)
  f32x16 pA0,pA1,pB0,pB1;
  int sl_prev=0,sl_cur=0,sl_next=SLOTB;
  #define ROT() do{sl_prev=sl_cur;sl_cur=sl_next;sl_next=(sl_next==(NSLOT-1)*SLOTB)?0:sl_next+SLOTB;}while(0)
  DMA_K(2,2*SLOTB);DMA_F(2,2*SLOTB);
  const lds_cptr shm3=(lds_cptr)shm;
  WAIT_BAR(6);
  CIN(pA0,pA1,0);
  qkt(pA0,pA1,Kbase,qr,r32,hi);asm volatile("s_nop 15\n\ts_nop 7":"+v"(pA0),"+v"(pA1));
  START(pA0,pA1);
  _Pragma("unroll") for(int r=0;r<16;++r)pA1[r]=__builtin_amdgcn_exp2f(pA1[r]);
  WAIT_BAR(0);
  DMA_K(3,0);DMA_F(3,0);DMA_V(1,SLOTB);
  ROT();
  kload8(kf,kp0+sl_cur);
  CIN(pB0,pB1,(sl_cur>>5));
  WAIT_BAR(3);
  s16x4 vlo[8],vhi[8]; u32x4 pw0,pw1,pw2,pw3;
  #define PKW(P,B) cvtpk_s(P[B],P[B+1])
  #define PAF(k) __builtin_bit_cast(bf16x8,pw##k)
  #define VFR(i) (bf16x8){vlo[i][0],vlo[i][1],vlo[i][2],vlo[i][3],vhi[i][0],vhi[i][1],vhi[i][2],vhi[i][3]}
  #define PIN(x) asm volatile("":"+v"(x))
  #define MX3(a,b,c) __builtin_fmaxf(__builtin_fmaxf((a),(b)),(c))
  #define GAPA(MF,A0,A1,A2,A3,W0,W1,PW) do{ MF; sacc+=A0; sacc+=A1; sacc+=A2; sacc+=A3; PIN(sacc); W0; W1; PIN(PW); SBAR(); }while(0)
  #define EX(v) __builtin_amdgcn_exp2f(v)
  #define GAPB(MF,X,B) do{ MF; X[B]=EX(X[B]); X[B+1]=EX(X[B+1]); X[B+2]=EX(X[B+2]); X[B+3]=EX(X[B+3]); PIN(X); SBAR(); }while(0)
  #define VRD(i) do{ vlo[i]=vtr(vp_+(((i)>>2)*4096+((i)&3)*1024)); vhi[i]=vtr(vp_+(((i)>>2)*4096+((i)&3)*1024+512)); }while(0)
  #define KRD(G,j) do{ if(G){ kload2(kf,kp0+sl_next,j); SBAR(); } }while(0)
  #define STEP(C0,C1,P0,P1,t,GK,GV,GL) do{ SBAR(); \
    const lds_cptr vp_=vp0+sl_prev; \
    VRD(0); SBAR(); float sacc=(P0[0]+P0[1]); \
    GAPA(C0=__builtin_amdgcn_mfma_f32_32x32x16_bf16(kf[0],qr[0],C0,0,0,0), P0[2],P0[3],P0[4],P0[5],     pw0[0]=PKW(P0,0), pw0[1]=PKW(P0,2), pw0); \
    VRD(4); SBAR(); GAPA(C1=__builtin_amdgcn_mfma_f32_32x32x16_bf16(kf[1],qr[0],C1,0,0,0), P0[6],P0[7],P0[8],P0[9],     pw0[2]=PKW(P0,4), pw0[3]=PKW(P0,6), pw0); \
    VRD(1); SBAR(); GAPA(C0=__builtin_amdgcn_mfma_f32_32x32x16_bf16(kf[2],qr[1],C0,0,0,0),   P0[10],P0[11],P0[12],P0[13], pw1[0]=PKW(P0,8), pw1[1]=PKW(P0,10), pw1); \
    VRD(5); SBAR(); GAPA(C1=__builtin_amdgcn_mfma_f32_32x32x16_bf16(kf[3],qr[1],C1,0,0,0),   P0[14],P0[15],P1[0],P1[1],   pw1[2]=PKW(P0,12),pw1[3]=PKW(P0,14), pw1); \
    VRD(2); SBAR(); GAPA(C0=__builtin_amdgcn_mfma_f32_32x32x16_bf16(kf[4],qr[2],C0,0,0,0),   P1[2],P1[3],P1[4],P1[5],     pw2[0]=PKW(P1,0), pw2[1]=PKW(P1,2), pw2); \
    VRD(6); SBAR(); GAPA(C1=__builtin_amdgcn_mfma_f32_32x32x16_bf16(kf[5],qr[2],C1,0,0,0),   P1[6],P1[7],P1[8],P1[9],     pw2[2]=PKW(P1,4), pw2[3]=PKW(P1,6), pw2); \
    VRD(3); SBAR(); GAPA(C0=__builtin_amdgcn_mfma_f32_32x32x16_bf16(kf[6],qr[3],C0,0,0,0),   P1[10],P1[11],P1[12],P1[13], pw3[0]=PKW(P1,8), pw3[1]=PKW(P1,10), pw3); \
    VRD(7); SBAR(); GAPA(C1=__builtin_amdgcn_mfma_f32_32x32x16_bf16(kf[7],qr[3],C1,0,0,0),   P1[14],P1[15],0.f,0.f,       pw3[2]=PKW(P1,12),pw3[3]=PKW(P1,14), pw3); \
    l_reg+=sacc; \
    if(GK){DMA_K((t)+3,sl_cur);DMA_F((t)+3,sl_cur);} if(GV){DMA_V((t)+1,sl_next);} \
    CMASK(C0,C1,t); \
    { float a=MX3(C0[0],C0[1],C1[0]),b=MX3(C0[2],C0[3],C1[1]); a=MX3(a,C1[2],C1[3]); \
      _Pragma("unroll") for(int r=4;r<16;r+=4){a=MX3(a,C0[r],C0[r+1]);b=MX3(b,C0[r+2],C0[r+3]);a=MX3(a,C1[r],C1[r+1]);b=MX3(b,C1[r+2],C1[r+3]);} \
      float rm=__builtin_fmaxf(a,b); { auto rr=__builtin_amdgcn_permlane32_swap(__float_as_uint(rm),__float_as_uint(rm),false,false); rm=__builtin_fmaxf(__uint_as_float(rr[0]),__uint_as_float(rr[1])); } \
      resc=false; \
      if(__builtin_expect(__any(rm>(float)THRL),0)){ const float dl=__builtin_fmaxf(rm,0.f); fqm-=dl; \
        _Pragma("unroll") for(int r=0;r<16;++r){C0[r]-=dl;C1[r]-=dl;} \
        const float f=__builtin_amdgcn_exp2f(-dl); l_reg*=f; if(hi==0)wsf[r32]=f; resc=true; } } \
    SBAR(); \
    GAPB(o[0]=__builtin_amdgcn_mfma_f32_32x32x16_bf16(PAF(0),VFR(0),o[0],0,0,0), C0,0); \
    GAPB(o[1]=__builtin_amdgcn_mfma_f32_32x32x16_bf16(PAF(0),VFR(4),o[1],0,0,0), C0,4); \
    KRD(GL,0); GAPB(o[0]=__builtin_amdgcn_mfma_f32_32x32x16_bf16(PAF(1),VFR(1),o[0],0,0,0), C0,8); \
    KRD(GL,1); GAPB(o[1]=__builtin_amdgcn_mfma_f32_32x32x16_bf16(PAF(1),VFR(5),o[1],0,0,0), C0,12); \
    KRD(GL,2); GAPB(o[0]=__builtin_amdgcn_mfma_f32_32x32x16_bf16(PAF(2),VFR(2),o[0],0,0,0), C1,0); \
    KRD(GL,3); GAPB(o[1]=__builtin_amdgcn_mfma_f32_32x32x16_bf16(PAF(2),VFR(6),o[1],0,0,0), C1,4); \
    GAPB(o[0]=__builtin_amdgcn_mfma_f32_32x32x16_bf16(PAF(3),VFR(3),o[0],0,0,0), C1,8); \
    GAPB(o[1]=__builtin_amdgcn_mfma_f32_32x32x16_bf16(PAF(3),VFR(7),o[1],0,0,0), C1,12); \
    if(GL){ CIN(P0,P1,(sl_next>>5)); } \
    }while(0)
  int t=1;
  #undef CMASK
  #define CMASK(P0,P1,t) do{}while(0)
  for(;t+5<NT;t+=2){
    STEP(pB0,pB1,pA0,pA1,t,true,true,true);     WAIT_BAR(3); RESC(); ROT();
    STEP(pA0,pA1,pB0,pB1,t+1,true,true,true);   WAIT_BAR(3); RESC(); ROT();
  }
  #undef CMASK
  #define CMASK(P0,P1,t) do{int jb_=(t)-(NT-4); if(jb_>=0)cmask(P0,P1,jb_,qrel,hi);}while(0)
  #define ENDW(tt) do{ if((tt)+3<NT){WAIT_BAR(3);} else if((tt)+2<NT){WAIT_BAR(1);} else {WAIT_BAR(0);} }while(0)
  for(;t+1<NT;t+=2){
    STEP(pB0,pB1,pA0,pA1,t,(t+3<NT),(t+1<NT),(t+1<NT));       ENDW(t);   RESC(); ROT();
    STEP(pA0,pA1,pB0,pB1,t+1,(t+4<NT),(t+2<NT),(t+2<NT));     ENDW(t+1); RESC(); ROT();
  }
  { float sacc=pA0[0]+pA0[1]; _Pragma("unroll") for(int r=2;r<16;++r)sacc+=pA0[r]; _Pragma("unroll") for(int r=0;r<16;++r)sacc+=pA1[r]; l_reg+=sacc;
    pw0=(u32x4){PKW(pA0,0),PKW(pA0,2),PKW(pA0,4),PKW(pA0,6)};pw1=(u32x4){PKW(pA0,8),PKW(pA0,10),PKW(pA0,12),PKW(pA0,14)};pw2=(u32x4){PKW(pA1,0),PKW(pA1,2),PKW(pA1,4),PKW(pA1,6)};pw3=(u32x4){PKW(pA1,8),PKW(pA1,10),PKW(pA1,12),PKW(pA1,14)};
    SBAR(); pv(o,vb0+sl_prev,PAF(0),PAF(1),PAF(2),PAF(3)); }
  #undef PKW
  #undef PAF
  #undef VFR
  #undef PIN
  #undef MX3
  #undef GAPA
  #undef GAPB
  #undef EX
  #undef VRD
  #undef KRD
  #undef STEP
  #undef ENDW
  {auto rr=__builtin_amdgcn_permlane32_swap(__float_as_uint(l_reg),__float_as_uint(l_reg),false,false);l_reg=__uint_as_float(rr[0])+__uint_as_float(rr[1]);}
  if(hi==0)wsf[32+r32]=l_reg;asm volatile("s_waitcnt lgkmcnt(0)":::"memory");
  float rli[16];
  #pragma unroll
  for(int r=0;r<16;++r)rli[r]=__builtin_amdgcn_rcpf(wsf[32+crow(r,hi)]);
  bf16*Ow=O+(rowbase+q0+wid*QBLK)*DM+h*D;
  { bf16*stg=(bf16*)(shm+LDS_OST)+wid*2048;
    #pragma unroll
    for(int r=0;r<16;++r){const int orow=crow(r,hi);
      #pragma unroll
      for(int d0=0;d0<2;++d0)stg[orow*64+d0*32+r32]=__float2bfloat16(o[d0][r]*rli[r]);}
    asm volatile("s_waitcnt lgkmcnt(0)":::"memory");
    #pragma unroll
    for(int i=0;i<4;++i){const int row=i*8+(lane>>3),ch=lane&7; const u32x4 v=*(const u32x4*)(stg+row*64+ch*8); ATTN_STORE16(Ow+(long)row*DM+ch*8,v);} }
  asm volatile("s_waitcnt lgkmcnt(0)\n\ts_barrier":::"memory");
  #undef DMA_K
  #undef DMA_V
  #undef DMA_F
  #undef DMA_KM
  #undef DMA_VM
  #undef DMA_FM
  #undef CIN
  #undef CMASK
  #undef START
  #undef RESC
  #undef ROT
}
constexpr int ATTN_LDS_BYTES=LDS_BYTES;
struct AttnTensors { const bf16* Q; const bf16* K; const bf16* V; const bf16* KM; const bf16* VM; const float* F2x; const float* F2m; bf16* O; };
struct AttnUnit { int bh; int qb; };
struct StaticOrder {
  int vcu;
  __device__ __forceinline__ explicit StaticOrder(int grid,int block):vcu((block%8)*(grid/8)+block/8){}
  __device__ __forceinline__ bool next(int i,AttnUnit&u)const{ if(i>=2)return false; const int s=vcu&15; u.bh=vcu>>4; u.qb=(i==0)?31-s:s; return true; }
  __device__ __forceinline__ void a_ready(const AttnUnit&)const{}
  __device__ __forceinline__ void done(const AttnUnit&)const{}
};
template<class Sched,int THRL=8> __device__ __forceinline__ void attn_phase(char*lds,const AttnTensors&T,const Sched&S){
  AttnUnit u;
  for(int i=0;S.next(i,u);++i){ S.a_ready(u); attn_unit<THRL>(u.bh/NHEAD,u.bh%NHEAD,u.qb,T.Q,T.K,T.V,T.KM,T.VM,T.F2x,T.F2m,T.O,lds); S.done(u); }
}
#undef SBAR
#undef WAIT_BAR
}
#define XB_TMO      128
#define XB_XCNT(j)  (256  + 64 * (j))
#define XB_XSUB(j)  (1280 + 64 * (j))
#define XB_XGEN(j)  (2304 + 64 * (j))
#define XB_TOP      3328
#define XB_TOPGEN   3392
#define XCD_BAR_WORDS 3456
#define XB_SPIN_CAP (1u << 18)
__device__ __forceinline__ unsigned xb_ld(unsigned* p)              { return __hip_atomic_load(p, __ATOMIC_RELAXED, __HIP_MEMORY_SCOPE_AGENT); }
__device__ __forceinline__ unsigned xb_add(unsigned* p, unsigned v) { return __hip_atomic_fetch_add(p, v, __ATOMIC_RELAXED, __HIP_MEMORY_SCOPE_AGENT); }
__device__ __forceinline__ unsigned xb_xcc_id() { return (unsigned)__builtin_amdgcn_s_getreg((3 << 11) | 20) & 0xFu; }
#define XB_SPIN(cond, bar) do { unsigned _sp = 0; while (cond) { __builtin_amdgcn_s_sleep(1); \
    if ((++_sp & 255u) == 0u) { if (xb_ld(&(bar)[XB_TMO])) break; if (_sp > XB_SPIN_CAP) { atomicAdd(&(bar)[XB_TMO], 1u); break; } } } } while (0)
struct XcdBarrier { unsigned* bar; unsigned x; volatile LAS unsigned* st; };
__device__ __forceinline__ XcdBarrier xcd_barrier_post(unsigned* bar, volatile LAS unsigned* st) {
    XcdBarrier b; b.bar = bar; b.x = xb_xcc_id(); b.st = st;
    if (threadIdx.x == 0) (void)xb_add(&bar[XB_XCNT(b.x)], 1u);
    return b;
}
__device__ __forceinline__ void xcd_barrier_complete(unsigned* bar, unsigned x, unsigned& nloc, unsigned& nx) {
    const unsigned G = gridDim.x * gridDim.y * gridDim.z;
    unsigned sum, cnt, mine, sp = 0u;
    for (;;) {
        sum = 0u; cnt = 0u; mine = 0u;
#pragma unroll
        for (unsigned j = 0; j < 16; ++j) { const unsigned c = xb_ld(&bar[XB_XCNT(j)]); sum += c; cnt += (c > 0u) ? 1u : 0u; mine = (j == x) ? c : mine; }
        if (sum == G) break;
        __builtin_amdgcn_s_sleep(1);
        if ((++sp & 255u) == 0u) { if (xb_ld(&bar[XB_TMO])) break; if (sp > XB_SPIN_CAP) { atomicAdd(&bar[XB_TMO], 1u); break; } }
    }
    nloc = mine > 0u ? mine : 1u; nx = cnt > 0u ? cnt : 1u;
}
__device__ __forceinline__ void xcd_barrier(const XcdBarrier& b) {
    asm volatile("s_waitcnt vmcnt(0)" ::: "memory");
    __syncthreads();
    if (threadIdx.x == 0) {
        unsigned* bar = b.bar;
        __builtin_amdgcn_s_waitcnt(0);
        unsigned nloc = b.st[0], nx = b.st[1];
        if (nloc == 0u) { xcd_barrier_complete(bar, b.x, nloc, nx); b.st[0] = nloc; b.st[1] = nx; }
        const unsigned old = xb_add(&bar[XB_XSUB(b.x)], 1u);
        const unsigned gen = old / nloc;
        if (old + 1u == (gen + 1u) * nloc) {
            __builtin_amdgcn_fence(__ATOMIC_RELEASE, "agent");
            asm volatile("s_waitcnt vmcnt(0)" ::: "memory");
            const unsigned og = xb_add(&bar[XB_TOP], 1u);
            const unsigned tg = og / nx;
            if (og + 1u == (tg + 1u) * nx) xb_add(&bar[XB_TOPGEN], 1u);
            else XB_SPIN(xb_ld(&bar[XB_TOPGEN]) == tg, bar);
            __builtin_amdgcn_fence(__ATOMIC_ACQUIRE, "agent");
            xb_add(&bar[XB_XGEN(b.x)], 1u);
            asm volatile("s_waitcnt vmcnt(0)" ::: "memory");
        } else {
            XB_SPIN(xb_ld(&bar[XB_XGEN(b.x)]) == gen, bar);
            __builtin_amdgcn_fence(__ATOMIC_ACQUIRE, "agent");
            asm volatile("s_waitcnt vmcnt(0)" ::: "memory");
        }
    }
    __syncthreads();
}

struct Frame {
    LAS unsigned char* lds; volatile LAS unsigned* MISC; unsigned* ctl; unsigned char* ws;
    int vcu, G;
    const float* in[31]; float* out;
};
enum InIdx { I_X = 0, I_META, I_LNG, I_LNB, I_WIN, I_BF, I_WUPA, I_WUPB, I_WO, I_ARE, I_AIM, I_LOGDT, I_BRE, I_BIM, I_CRE, I_CIM, I_SD, I_WGLU, I_BGLU, I_LN1G, I_LN1B,
             I_WR, I_BR, I_WG, I_BG, I_WU, I_BU, I_WD, I_BD, I_LN2G, I_LN2B };

__device__ __forceinline__ void p0_transpose_item(const float* W, int ldw, int K, int k0, int n0s, bf16* WT, int drow0, LAS float* scr, int lane) {
#pragma unroll 8
    for (int i = 0; i < 32; ++i) { const int kk = 2 * i + (lane >> 5); scr[kk * 33 + (lane & 31)] = W[(size_t)(k0 + kk) * ldw + n0s + (lane & 31)]; }
    LDS_WAIT(); asm volatile("" ::: "memory");
    const int c = lane & 7;
#pragma unroll
    for (int j = 0; j < 4; ++j) { const int n = (lane >> 3) + 8 * j; const LAS float* s = scr + (8 * c) * 33 + n;
        u32x4 o; o.x = pk2(s[0 * 33], s[1 * 33]); o.y = pk2(s[2 * 33], s[3 * 33]); o.z = pk2(s[4 * 33], s[5 * 33]); o.w = pk2(s[6 * 33], s[7 * 33]);
        *(u32x4*)(WT + (size_t)(drow0 + n) * K + k0 + 8 * c) = o; }
    LDS_WAIT(); asm volatile("" ::: "memory");
}
__device__ __forceinline__ void ln_row_stats(const float* xrow, int lane, f32x4 (&v)[4]) {
    const f32x4* xr = (const f32x4*)xrow + lane; float s = 0.f;
#pragma unroll
    for (int j = 0; j < 4; ++j) { v[j] = xr[64 * j]; s += (v[j].x + v[j].y) + (v[j].z + v[j].w); }
    const float mean = wave_sum(s) * (1.f / D); float s2 = 0.f;
#pragma unroll
    for (int j = 0; j < 4; ++j) { v[j] = v[j] - mean; s2 += (v[j].x * v[j].x + v[j].y * v[j].y) + (v[j].z * v[j].z + v[j].w * v[j].w); }
    const float rstd = 1.f / sqrtf(wave_sum(s2) * (1.f / D) + LN_EPS);
#pragma unroll
    for (int j = 0; j < 4; ++j) v[j] = v[j] * rstd;
}

__device__ __forceinline__ void p0_prologue(Frame& F) {
    const int tid_ = fresh_tid(), lane = tid_ & 63, wave = __builtin_amdgcn_readfirstlane(tid_ >> 6);
    const float* lng = F.in[I_LNG]; const float* lnb = F.in[I_LNB]; const float* w_in = F.in[I_WIN];
    f32x4 gv[4], bv[4];
#pragma unroll
    for (int j = 0; j < 4; ++j) { gv[j] = *((const f32x4*)lng + lane + 64 * j); bv[j] = *((const f32x4*)lnb + lane + 64 * j); }
    if (blockIdx.x < 25) {
        LAS float* hm = (LAS float*)F.lds;
        LAS float* red = (LAS float*)(F.lds + 65536);
#pragma unroll
        for (int rr = 0; rr < 2; ++rr) { const int r = 2 * wave + rr; f32x4 v[4]; ln_row_stats(F.in[I_META] + (size_t)r * D, lane, v);
#pragma unroll
            for (int j = 0; j < 4; ++j) { const f32x4 h = v[j] * gv[j] + bv[j]; const int k = 256 * j + 4 * lane;
                hm[(k + 0) * 16 + r] = h.x; hm[(k + 1) * 16 + r] = h.y; hm[(k + 2) * 16 + r] = h.z; hm[(k + 3) * 16 + r] = h.w; } }
        __syncthreads();
        const int col = 512 + 64 * (int)blockIdx.x + lane; const bool valid = col < GA_OFF;
        float acc[16];
#pragma unroll
        for (int r = 0; r < 16; ++r) acc[r] = 0.f;
        for (int k = 128 * wave; k < 128 * wave + 128; ++k) { const float wv = valid ? w_in[(size_t)k * IN_COLS + col] : 0.f;
            const LAS f32x4* hp = (const LAS f32x4*)(hm + k * 16);
#pragma unroll
            for (int q = 0; q < 4; ++q) { const f32x4 h = hp[q]; acc[4 * q + 0] += h.x * wv; acc[4 * q + 1] += h.y * wv; acc[4 * q + 2] += h.z * wv; acc[4 * q + 3] += h.w * wv; } }
#pragma unroll
        for (int r = 0; r < 16; ++r) red[(wave * 16 + r) * 64 + lane] = acc[r];
        __syncthreads();
        unsigned char* sm = F.ws + WS_SMALL;
#pragma unroll
        for (int rr = 0; rr < 2; ++rr) { const int r = 2 * wave + rr; float s = 0.f;
#pragma unroll
            for (int w = 0; w < 8; ++w) s += red[(w * 16 + r) * 64 + lane];
            if (valid) {
                if (col < 1024) ((bf16*)(sm + SM_KMETA))[r * AW + col - 512] = (bf16)f2bf(s);
                else if (col < F_OFF) ((bf16*)(sm + SM_VMETA))[r * AW + col - 1024] = (bf16)f2bf(s);
                else if (col < U_OFF) ((float*)(sm + SM_LOGFM))[r * 8 + col - F_OFF] = log_sigmoidf_(s + F.in[I_BF][col - F_OFF]);
                else ((float*)(sm + SM_UMETA))[r * SW + col - U_OFF] = s;
            } }
        __syncthreads();
    }
    if (blockIdx.x == 25) {
        u32x4* kz = (u32x4*)(F.ws + WS_SMALL + SM_KMETA + 16 * AW * 2); u32x4* vz = (u32x4*)(F.ws + WS_SMALL + SM_VMETA + 16 * AW * 2);
        for (int i = tid_; i < 48 * AW * 2 / 16; i += NWAVES * 64) { kz[i] = (u32x4){0u, 0u, 0u, 0u}; vz[i] = (u32x4){0u, 0u, 0u, 0u}; }
    }
    if (blockIdx.x >= 26 && blockIdx.x < 26 + NG) {
        const int g = (int)blockIdx.x - 26;
        LAS float* Apr = (LAS float*)F.lds; LAS float* Api = Apr + 17 * 64;
        LAS float* Bbr = Api + 17 * 64; LAS float* Bbi = Bbr + 1024;
        LAS float* Cr = Bbi + 1024; LAS float* Ci = Cr + 1024;
        LAS float* Kt = Ci + 1024;
        if (tid_ < 64) { const int p = tid_;
            const float dt = __expf(F.in[I_LOGDT][g]); const float are = F.in[I_ARE][g * NP + p], aim = F.in[I_AIM][g * NP + p];
            const float mag = __expf(are * dt); float sn, cs; sincos_acc(aim * dt, sn, cs);
            const float lbr = mag * cs, lbi = mag * sn, den = are * are + aim * aim, zr = lbr - 1.0f, zi = lbi;
            const float cfr = (zr * are + zi * aim) / den, cfi = (zi * are - zr * aim) / den;
            for (int c = 0; c < 16; ++c) { const float br = F.in[I_BRE][((size_t)g * NP + p) * GC + c], bi = F.in[I_BIM][((size_t)g * NP + p) * GC + c];
                Bbr[p * 16 + c] = cfr * br - cfi * bi; Bbi[p * 16 + c] = cfr * bi + cfi * br; }
            float pr = 1.0f, pi = 0.0f;
            for (int n = 0; n <= 16; ++n) { Apr[n * 64 + p] = pr; Api[n * 64 + p] = pi; const float nr = pr * lbr - pi * lbi, ni = pr * lbi + pi * lbr; pr = nr; pi = ni; } }
        for (int i = tid_; i < 1024; i += NWAVES * 64) { Cr[i] = F.in[I_CRE][(size_t)g * 1024 + i]; Ci[i] = F.in[I_CIM][(size_t)g * 1024 + i]; }
        __syncthreads();
        for (int idx = tid_; idx < 4096; idx += NWAVES * 64) { const int tau = idx >> 8, cp = (idx >> 4) & 15, c = idx & 15; float sacc = 0.f;
            for (int p = 0; p < 64; ++p) { const float ar = Apr[tau * 64 + p], ai = Api[tau * 64 + p], br = Bbr[p * 16 + c], bi = Bbi[p * 16 + c];
                const float er = ar * br - ai * bi, ei = ar * bi + ai * br; sacc += Cr[cp * 64 + p] * er - Ci[cp * 64 + p] * ei; }
            Kt[idx] = sacc + ((tau == 0 && cp == c) ? F.in[I_SD][g * GC + cp] : 0.f); }
        __syncthreads();
        bf16* WY = (bf16*)(F.ws + WS_WY) + (size_t)g * 256 * 384; bf16* WSg = (bf16*)(F.ws + WS_WSS) + (size_t)g * 256 * 256;
        for (int q = tid_; q < 256 * 48; q += NWAVES * 64) { const int n = q / 48, k0 = (q - n * 48) * 8, jp = n >> 4, cp = n & 15; float v[8];
            if (k0 < 256) { const int j = k0 >> 4, c0 = k0 & 15;
#pragma unroll
                for (int i = 0; i < 8; ++i) v[i] = (j <= jp) ? Kt[((jp - j) * 16 + cp) * 16 + c0 + i] : 0.f; }
            else { const int ks = k0 - 256, p0 = ks & 63; const bool im = ks >= 64;
#pragma unroll
                for (int i = 0; i < 8; ++i) { const int p = p0 + i; const float ar = Apr[(jp + 1) * 64 + p], ai = Api[(jp + 1) * 64 + p], cr = Cr[cp * 64 + p], ci = Ci[cp * 64 + p];
                    v[i] = im ? -(cr * ai + ci * ar) : (cr * ar - ci * ai); } }
            u32x4 o; o.x = pk2(v[0], v[1]); o.y = pk2(v[2], v[3]); o.z = pk2(v[4], v[5]); o.w = pk2(v[6], v[7]); *(u32x4*)(WY + (size_t)n * 384 + k0) = o; }
        for (int q = tid_; q < 256 * 32; q += NWAVES * 64) { const int n = q >> 5, k0 = (q & 31) * 8, j = k0 >> 4, c0 = k0 & 15; float v[8];
            if (n < 128) { const int p = n & 63; const bool im = n >= 64; const float ar = Apr[(15 - j) * 64 + p], ai = Api[(15 - j) * 64 + p];
#pragma unroll
                for (int i = 0; i < 8; ++i) { const float br = Bbr[p * 16 + c0 + i], bi = Bbi[p * 16 + c0 + i]; v[i] = im ? (ar * bi + ai * br) : (ar * br - ai * bi); } }
            else {
#pragma unroll
                for (int i = 0; i < 8; ++i) v[i] = 0.f; }
            u32x4 o; o.x = pk2(v[0], v[1]); o.y = pk2(v[2], v[3]); o.z = pk2(v[4], v[5]); o.w = pk2(v[6], v[7]); *(u32x4*)(WSg + (size_t)n * 256 + k0) = o; }
        __syncthreads();
    }
    {
        LAS float* scr = (LAS float*)(F.lds + wave * 16384);
        const int gw = F.vcu * NWAVES + wave, NGW = F.G * NWAVES;
        constexpr int I_IN = 16 * 128, I_UA = 8 * 32, I_UB = 8 * 32, I_O = 16 * 32, I_GL = 8 * 16, I_GU = 16 * 64, I_DN = 16 * 32;
        constexpr int NDENSE = I_IN + I_UA + I_UB + I_O + I_GL, NITEMS = NDENSE + NE * (I_GU + I_DN);
        for (int it = gw; it < NITEMS; it += NGW) {
            int r = it;
            if (r < I_IN) { const int kb = r / 128, nb = r % 128, n0 = 32 * nb; p0_transpose_item(w_in, IN_COLS, D, 64 * kb, n0 + (n0 >= F_OFF ? 8 : 0), (bf16*)(F.ws + WS_WIN), n0, scr, lane); continue; } r -= I_IN;
            if (r < I_UA) { const int kb = r / 32, nb = r % 32; p0_transpose_item(F.in[I_WUPA], D, AW, 64 * kb, 32 * nb, (bf16*)(F.ws + WS_WUPA), 32 * nb, scr, lane); continue; } r -= I_UA;
            if (r < I_UB) { const int kb = r / 32, nb = r % 32; p0_transpose_item(F.in[I_WUPB], D, SW, 64 * kb, 32 * nb, (bf16*)(F.ws + WS_WUPB), 32 * nb, scr, lane); continue; } r -= I_UB;
            if (r < I_O) { const int kb = r / 32, nb = r % 32; p0_transpose_item(F.in[I_WO], D, D, 64 * kb, 32 * nb, (bf16*)(F.ws + WS_WO), 32 * nb, scr, lane); continue; } r -= I_O;
            if (r < I_GL) { const int kb = r / 16, nb = r % 16; p0_transpose_item(F.in[I_WGLU], SW, SW, 64 * kb, 32 * nb, (bf16*)(F.ws + WS_WGLU), 32 * nb, scr, lane); continue; } r -= I_GL;
            const int e = r / (I_GU + I_DN); r -= e * (I_GU + I_DN);
            if (r < I_GU) { const int kb = r / 64, nb = r % 64, dr = 32 * nb, pn = dr >> 8, jj = dr & 255;
                const float* src = (jj < 128 ? F.in[I_WG] : F.in[I_WU]) + (size_t)e * D * D; const int sc = pn * 128 + (jj & 127);
                p0_transpose_item(src, D, D, 64 * kb, sc, (bf16*)(F.ws + WS_WGU) + (size_t)e * 2048 * D, dr, scr, lane); continue; } r -= I_GU;
            { const int kb = r / 32, nb = r % 32; p0_transpose_item(F.in[I_WD] + (size_t)e * D * D, D, D, 64 * kb, 32 * nb, (bf16*)(F.ws + WS_WD) + (size_t)e * D * D, 32 * nb, scr, lane); }
        }
        float wf[16][8];
#pragma unroll
        for (int j = 0; j < 4; ++j)
#pragma unroll
            for (int i = 0; i < 4; ++i) { const float* p = w_in + (size_t)(256 * j + 4 * lane + i) * IN_COLS + F_OFF; const f32x4 a = *(const f32x4*)p, b = *(const f32x4*)(p + 4);
                wf[4 * j + i][0] = a.x; wf[4 * j + i][1] = a.y; wf[4 * j + i][2] = a.z; wf[4 * j + i][3] = a.w; wf[4 * j + i][4] = b.x; wf[4 * j + i][5] = b.y; wf[4 * j + i][6] = b.z; wf[4 * j + i][7] = b.w; }
        const float bfl = F.in[I_BF][lane & 7];
        bf16* XN = (bf16*)(F.ws + WS_XN); float* logf = (float*)(F.ws + WS_LOGF);
        for (int m = gw; m < M; m += NGW) {
            f32x4 v[4]; ln_row_stats(F.in[I_X] + (size_t)m * D, lane, v);
            float fs[8];
#pragma unroll
            for (int h = 0; h < 8; ++h) fs[h] = 0.f;
            unsigned long long* o8 = (unsigned long long*)(XN + (size_t)m * D) + lane;
#pragma unroll
            for (int j = 0; j < 4; ++j) { const f32x4 h = v[j] * gv[j] + bv[j];
                o8[64 * j] = (unsigned long long)pk2(h.x, h.y) | ((unsigned long long)pk2(h.z, h.w) << 32);
#pragma unroll
                for (int hh = 0; hh < 8; ++hh) fs[hh] += h.x * wf[4 * j + 0][hh] + h.y * wf[4 * j + 1][hh] + h.z * wf[4 * j + 2][hh] + h.w * wf[4 * j + 3][hh]; }
#pragma unroll
            for (int hh = 0; hh < 8; ++hh) fs[hh] = wave_sum(fs[hh]);
            const int l7 = lane & 7;
            const float mine = (l7 == 0) ? fs[0] : (l7 == 1) ? fs[1] : (l7 == 2) ? fs[2] : (l7 == 3) ? fs[3] : (l7 == 4) ? fs[4] : (l7 == 5) ? fs[5] : (l7 == 6) ? fs[6] : fs[7];
            if (lane < 8) logf[(size_t)m * 8 + lane] = log_sigmoidf_(mine + bfl);
        }
    }
}

__device__ __forceinline__ void p1_fcumsum(Frame& F) {
    const int tid_ = fresh_tid(), lane = tid_ & 63, wave_ = __builtin_amdgcn_readfirstlane(tid_ >> 6);
    if (blockIdx.x >= 16 || wave_ != 0) return;
    const int b = blockIdx.x >> 3, h = blockIdx.x & 7;
    const float* logfm = (const float*)(F.ws + WS_SMALL + SM_LOGFM); float* F2m = (float*)(F.ws + WS_SMALL + SM_F2M);
    float mt = 0.f;
    for (int j = 0; j < NMETA; ++j) { mt += logfm[j * 8 + h]; if (b == 0 && lane == 0) F2m[h * 64 + j] = mt * LOG2E; }
    if (b == 0 && lane >= NMETA) F2m[h * 64 + lane] = INFINITY;
    const float* lf = (const float*)(F.ws + WS_LOGF) + (size_t)b * SEQ * 8 + h; float* F2x = (float*)(F.ws + WS_F2X) + (size_t)(b * 8 + h) * SEQ;
    float s = 0.f;
    for (int i = 0; i < 128; ++i) s += lf[(size_t)(128 * lane + i) * 8];
    float inc = s;
#pragma unroll
    for (int o = 1; o < 64; o <<= 1) { const float t = __shfl_up(inc, o); if (lane >= o) inc += t; }
    float run = mt + (inc - s);
    for (int i = 0; i < 128; ++i) { run += lf[(size_t)(128 * lane + i) * 8]; F2x[128 * lane + i] = run * LOG2E; }
}

__device__ __forceinline__ void ssm_chunk_scan(Frame& F, int b, int g, int lane) {
    const int p = lane;
    const float dt = __expf(F.in[I_LOGDT][g]); const float are = F.in[I_ARE][g * NP + p], aim = F.in[I_AIM][g * NP + p];
    const float mag = __expf(are * dt); float sn, cs; sincos_acc(aim * dt, sn, cs);
    const float lbr = mag * cs, lbi = mag * sn, den = are * are + aim * aim, zr = lbr - 1.0f, zi = lbi;
    const float cfr = (zr * are + zi * aim) / den, cfi = (zi * are - zr * aim) / den;
    float bbr[16], bbi[16];
#pragma unroll
    for (int c = 0; c < 16; ++c) { const float br = F.in[I_BRE][((size_t)g * NP + p) * GC + c], bi = F.in[I_BIM][((size_t)g * NP + p) * GC + c]; bbr[c] = cfr * br - cfi * bi; bbi[c] = cfr * bi + cfi * br; }
    const float* Um = (const float*)(F.ws + WS_SMALL + SM_UMETA) + g * GC;
    float xr = 0.f, xi = 0.f;
    for (int j = 0; j < NMETA; ++j) { float bur = 0.f, bui = 0.f;
#pragma unroll
        for (int c = 0; c < 16; ++c) { const float u = Um[(size_t)j * SW + c]; bur += bbr[c] * u; bui += bbi[c] * u; }
        const float nr = lbr * xr - lbi * xi + bur, ni = lbr * xi + lbi * xr + bui; xr = nr; xi = ni; }
    float ar = lbr, ai = lbi;
#pragma unroll
    for (int q = 0; q < 4; ++q) { const float nr = ar * ar - ai * ai, ni = 2.0f * ar * ai; ar = nr; ai = ni; }
    const float* SS = (const float*)(F.ws + WS_SS) + ((size_t)g * 1024 + (size_t)b * 512) * 128;
    bf16* XP = (bf16*)(F.ws + WS_U3) + ((size_t)g * 1024 + (size_t)b * 512) * 384 + 256;
    for (int c0 = 0; c0 < 512; c0 += 8) { float sr[8], si[8];
#pragma unroll
        for (int i = 0; i < 8; ++i) { sr[i] = SS[(size_t)(c0 + i) * 128 + p]; si[i] = SS[(size_t)(c0 + i) * 128 + 64 + p]; }
#pragma unroll
        for (int i = 0; i < 8; ++i) { XP[(size_t)(c0 + i) * 384 + p] = (bf16)f2bf(xr); XP[(size_t)(c0 + i) * 384 + 64 + p] = (bf16)f2bf(xi);
            const float nr = ar * xr - ai * xi + sr[i], ni = ar * xi + ai * xr + si[i]; xr = nr; xi = ni; } }
}
__device__ __forceinline__ void ssm_job(Frame& F0, int b, int g) {
    using namespace pg8;
    Frame F = F0; { unsigned char* w_ = F.ws; asm volatile("" : "+s"(w_)); F.ws = w_; }
    { SsmSched S; S.A = (const char*)(F.ws + WS_U3) + (size_t)g * 1024 * 384 * 2; S.Bt = (const char*)(F.ws + WS_WSS) + (size_t)g * 256 * 256 * 2; S.a_tstep = (size_t)BM * 384 * 2; S.pm0 = 2 * b; S.g = g;
      EpiS E{(float*)(F.ws + WS_SS)};
      int K1 = 256; asm volatile("" : "+s"(K1));
      gemm_phase<EpiS, SsmSched, true, false>(F.lds, K1, 384, 256, S, E); }
    __syncthreads();
    { const int tid_ = fresh_tid(); if ((tid_ >> 6) == 0) ssm_chunk_scan(F, b, g, tid_ & 63); }
    VM_WAIT(); __syncthreads();
    { SsmSched S; S.A = (const char*)(F.ws + WS_U3) + (size_t)g * 1024 * 384 * 2; S.Bt = (const char*)(F.ws + WS_WY) + (size_t)g * 256 * 384 * 2; S.a_tstep = (size_t)BM * 384 * 2; S.pm0 = 2 * b; S.g = g;
      EpiY E{(bf16*)(F.ws + WS_YB)};
      int K3 = 384; asm volatile("" : "+s"(K3));
      gemm_phase<EpiY, SsmSched, true, false>(F.lds, K3, 384, 384, S, E); }
}
__device__ __forceinline__ int fetch_job(Frame& F) {
    volatile LAS int* slot = (volatile LAS int*)(F.MISC + 16);
    if (threadIdx.x == 0) *slot = (int)__hip_atomic_fetch_add(F.ctl + CW_QHEAD, 1u, RLX_AGENT);
    __syncthreads(); const int j = *slot; __syncthreads(); return j;
}

__device__ __forceinline__ void p6_ln1_router(Frame& F) {
    const int tid_ = fresh_tid(), lane = tid_ & 63, wave = __builtin_amdgcn_readfirstlane(tid_ >> 6);
    const int gw = F.vcu * NWAVES + wave, NGW = F.G * NWAVES;
    const f32x4* gp = (const f32x4*)F.in[I_LN1G] + lane; const f32x4* bp = (const f32x4*)F.in[I_LN1B] + lane;
    const float* MIX = (const float*)(F.ws + WS_MIX); bf16* H1B = (bf16*)(F.ws + WS_H1B); const float* wr = F.in[I_WR];
    const int emine = (lane >> 1) & 31; const float brm = F.in[I_BR][emine];
    const bool b5 = lane & 32, b4 = lane & 16, b3 = lane & 8, b2 = lane & 4, b1 = lane & 2;
    int* list = (int*)(F.ws + WS_LIST); float* wslot = (float*)(F.ws + WS_WSLOT); unsigned* cnt = F.ctl + CW_CNT;
    for (int m = gw; m < M; m += NGW) {
        const f32x4* xr = (const f32x4*)(MIX + (size_t)m * D) + lane;
        float mean, rstd;
        { f32x4 v[4]; float s = 0.f;
#pragma unroll
          for (int j = 0; j < 4; ++j) { v[j] = xr[64 * j]; s += (v[j].x + v[j].y) + (v[j].z + v[j].w); }
          mean = wave_sum(s) * (1.f / D); float s2 = 0.f;
#pragma unroll
          for (int j = 0; j < 4; ++j) { const f32x4 d = v[j] - mean; s2 += (d.x * d.x + d.y * d.y) + (d.z * d.z + d.w * d.w); }
          rstd = 1.f / sqrtf(wave_sum(s2) * (1.f / D) + LN_EPS); }
        float part[32];
#pragma unroll
        for (int e = 0; e < 32; ++e) part[e] = 0.f;
        unsigned long long* o8 = (unsigned long long*)(H1B + (size_t)m * D) + lane;
#pragma unroll 1
        for (int j = 0; j < 4; ++j) { const f32x4 h = (xr[64 * j] - mean) * rstd * gp[64 * j] + bp[64 * j];
            o8[64 * j] = (unsigned long long)pk2(h.x, h.y) | ((unsigned long long)pk2(h.z, h.w) << 32);
            const f32x4* wpj = (const f32x4*)(wr + (size_t)(256 * j + 4 * lane) * NE);
#pragma unroll
            for (int i = 0; i < 4; ++i) { const float hv = h[i]; const f32x4* wp = wpj + i * 8;
#pragma unroll
                for (int q = 0; q < 8; ++q) { const f32x4 w = wp[q]; part[4 * q] += hv * w.x; part[4 * q + 1] += hv * w.y; part[4 * q + 2] += hv * w.z; part[4 * q + 3] += hv * w.w; } } }
        float r16[16], r8[8], r4[4], r2[2], r1;
#pragma unroll
        for (int i = 0; i < 16; ++i) { const float keep = b5 ? part[i + 16] : part[i], send = b5 ? part[i] : part[i + 16]; r16[i] = keep + __shfl_xor(send, 32); }
#pragma unroll
        for (int i = 0; i < 8; ++i) { const float keep = b4 ? r16[i + 8] : r16[i], send = b4 ? r16[i] : r16[i + 8]; r8[i] = keep + __shfl_xor(send, 16); }
#pragma unroll
        for (int i = 0; i < 4; ++i) { const float keep = b3 ? r8[i + 4] : r8[i], send = b3 ? r8[i] : r8[i + 4]; r4[i] = keep + __shfl_xor(send, 8); }
#pragma unroll
        for (int i = 0; i < 2; ++i) { const float keep = b2 ? r4[i + 2] : r4[i], send = b2 ? r4[i] : r4[i + 2]; r2[i] = keep + __shfl_xor(send, 4); }
        { const float keep = b1 ? r2[1] : r2[0], send = b1 ? r2[0] : r2[1]; r1 = keep + __shfl_xor(send, 2); }
        r1 += __shfl_xor(r1, 1);
        float val = r1 + brm;
        float tv[4]; int ti[4];
#pragma unroll
        for (int k = 0; k < 4; ++k) { float bvv = val; int bi = emine;
#pragma unroll
            for (int o = 2; o < 64; o <<= 1) { const float ov = __shfl_xor(bvv, o); const int oi = __shfl_xor(bi, o); if (ov > bvv || (ov == bvv && oi < bi)) { bvv = ov; bi = oi; } }
            tv[k] = bvv; ti[k] = bi; if (emine == bi) val = -INFINITY; }
        const float e1 = __expf(tv[1] - tv[0]), e2 = __expf(tv[2] - tv[0]), e3 = __expf(tv[3] - tv[0]), rs = 1.0f / (1.0f + e1 + e2 + e3);
        if (lane < 4) { const int ek = (lane == 0) ? ti[0] : (lane == 1) ? ti[1] : (lane == 2) ? ti[2] : ti[3]; const float wk = ((lane == 0) ? 1.0f : (lane == 1) ? e1 : (lane == 2) ? e2 : e3) * rs;
            const unsigned pos = __hip_atomic_fetch_add(cnt + ek, 1u, RLX_AGENT);
            list[(size_t)ek * LIST_CAP + pos] = 4 * m + lane; wslot[4 * m + lane] = wk; }
    }
}
__device__ __forceinline__ int moe_tables(Frame& F) {
    LAS int* tab = (LAS int*)(F.lds + TAB_OFF);
    if (fresh_tid() == 0) { int ts = 0; for (int e = 0; e < NE; ++e) { const int c = (int)__hip_atomic_load(F.ctl + CW_CNT + e, RLX_AGENT); tab[e] = ts; tab[40 + e] = c; ts += (c + 255) >> 8; } tab[32] = ts; }
    __syncthreads();
    return tab[32];
}
__device__ __forceinline__ void p9_final(Frame& F) {
    const int tid_ = fresh_tid(), lane = tid_ & 63, wave = __builtin_amdgcn_readfirstlane(tid_ >> 6);
    const int gw = F.vcu * NWAVES + wave, NGW = F.G * NWAVES;
    f32x4 gv[4], bv[4];
#pragma unroll
    for (int j = 0; j < 4; ++j) { gv[j] = *((const f32x4*)F.in[I_LN2G] + lane + 64 * j); bv[j] = *((const f32x4*)F.in[I_LN2B] + lane + 64 * j); }
    const bf16* H1B = (const bf16*)(F.ws + WS_H1B); const bf16* YS = (const bf16*)(F.ws + WS_YS);
    for (int m = gw; m < M; m += NGW) {
        f32x4 v[4]; float s = 0.f;
#pragma unroll
        for (int j = 0; j < 4; ++j) { const u32x2 h = *((const u32x2*)(H1B + (size_t)m * D) + lane + 64 * j); f32x4 a = (f32x4){bflo(h.x), bfhi(h.x), bflo(h.y), bfhi(h.y)} * ALPHA;
#pragma unroll
            for (int k = 0; k < 4; ++k) { const u32x2 y = *((const u32x2*)(YS + (size_t)(4 * m + k) * D) + lane + 64 * j); a = a + (f32x4){bflo(y.x), bfhi(y.x), bflo(y.y), bfhi(y.y)}; }
            v[j] = a; s += (a.x + a.y) + (a.z + a.w); }
        const float mean = wave_sum(s) * (1.f / D); float s2 = 0.f;
#pragma unroll
        for (int j = 0; j < 4; ++j) { v[j] = v[j] - mean; s2 += (v[j].x * v[j].x + v[j].y * v[j].y) + (v[j].z * v[j].z + v[j].w * v[j].w); }
        const float rstd = 1.f / sqrtf(wave_sum(s2) * (1.f / D) + LN_EPS);
        f32x4* op = (f32x4*)(F.out + (size_t)m * D) + lane;
#pragma unroll
        for (int j = 0; j < 4; ++j) op[64 * j] = v[j] * rstd * gv[j] + bv[j];
    }
}

struct Args { const float* in[31]; float* out; unsigned char* ws; int ph_lo, ph_hi, li, pad; };
__global__ void __launch_bounds__(NWAVES * 64, 2) fwd_kernel(Args args) {
    extern __shared__ __attribute__((aligned(16))) unsigned char lds_raw[];
    Frame F;
    F.lds = (LAS unsigned char*)lds_raw; F.MISC = (volatile LAS unsigned*)(F.lds + MISC_OFF);
    F.G = gridDim.x; { const int bx = blockIdx.x; F.vcu = (F.G % 8 == 0) ? (bx % 8) * (F.G / 8) + bx / 8 : bx; }
    F.ws = args.ws; F.ctl = (unsigned*)(args.ws + WS_CTL); F.out = args.out;
#pragma unroll
    for (int i = 0; i < 31; ++i) F.in[i] = args.in[i];
    for (int u = threadIdx.x; u < (LDS_BYTES - LDSCTL_OFF) / 4; u += NWAVES * 64) ((LAS unsigned*)(F.lds + LDSCTL_OFF))[u] = 0u;
    __syncthreads();
    XcdBarrier bar; bar.bar = F.ctl + CW_BAR; bar.x = 0; bar.st = nullptr;
    if (MK_N_LAUNCHES == 1) bar = xcd_barrier_post(F.ctl + CW_BAR, F.MISC + 8);
#define GRID_BAR() do { if (MK_N_LAUNCHES == 1) xcd_barrier(bar); } while (0)
    const int lo = args.ph_lo, hi = args.ph_hi;
#define IN(k) (lo <= (k) && (k) < hi)
#define BOTH(k) (IN(k) && IN((k) + 1))
    using namespace pg8;
    LAS unsigned char* ring = F.lds;

    if (IN(0)) { p0_prologue(F); if (BOTH(0)) GRID_BAR(); }

    if (IN(1)) {
        p1_fcumsum(F);
        DenseSched S; S.init(M, 4096, F.G, (int)blockIdx.x); S.A = (const char*)(F.ws + WS_XN); S.Bt = (const char*)(F.ws + WS_WIN); S.a_tstep = (size_t)BM * D * 2; S.b_tstep = (size_t)BM * D * 2;
        EpiInProj E{(bf16*)(F.ws + WS_Q), (bf16*)(F.ws + WS_K), (bf16*)(F.ws + WS_V), (bf16*)(F.ws + WS_U3), (bf16*)(F.ws + WS_GA), (bf16*)(F.ws + WS_GB)};
        gemm_phase<EpiInProj, DenseSched, true, false>(ring, D, D, D, S, E);
        if (BOTH(1)) GRID_BAR();
    }
    if (IN(2)) {
        static_assert(attn_body::ATTN_LDS_BYTES <= RING_BYTES, "attention LDS");
        int j = fetch_job(F);
        while (j < 64) { ssm_job(F, j >> 5, j & 31); j = fetch_job(F); }
        while (j < 64 + 512) { const int a = j - 64, qb = 31 - (a >> 4), bh = a & 15;
            attn_body::attn_unit<8>(bh >> 3, bh & 7, qb, (const attn_body::bf16*)(F.ws + WS_Q), (const attn_body::bf16*)(F.ws + WS_K), (const attn_body::bf16*)(F.ws + WS_V),
                (const attn_body::bf16*)(F.ws + WS_SMALL + SM_KMETA), (const attn_body::bf16*)(F.ws + WS_SMALL + SM_VMETA), (const float*)(F.ws + WS_F2X), (const float*)(F.ws + WS_SMALL + SM_F2M),
                (attn_body::bf16*)(F.ws + WS_YA), (char*)lds_raw);
            j = fetch_job(F); }
        if (BOTH(2)) GRID_BAR();
    }
    if (IN(3)) {
        { DenseSched S; S.init(M, SW, F.G, (int)blockIdx.x); S.A = (const char*)(F.ws + WS_YB); S.Bt = (const char*)(F.ws + WS_WGLU); S.a_tstep = (size_t)BM * SW * 2; S.b_tstep = (size_t)BM * SW * 2;
          EpiGate<0> E{(bf16*)(F.ws + WS_YG), (const bf16*)(F.ws + WS_YB), nullptr, F.in[I_BGLU], SW};
          gemm_phase<EpiGate<0>, DenseSched, true, false>(ring, SW, SW, SW, S, E); }
        { DenseSched S; S.init(M, D, F.G, (int)blockIdx.x); S.A = (const char*)(F.ws + WS_YA); S.Bt = (const char*)(F.ws + WS_WUPA); S.a_tstep = (size_t)BM * AW * 2; S.b_tstep = (size_t)BM * AW * 2;
          EpiGate<1> E{(bf16*)(F.ws + WS_T1), nullptr, (const bf16*)(F.ws + WS_GA), nullptr, D};
          gemm_phase<EpiGate<1>, DenseSched, true, false>(ring, AW, AW, AW, S, E); }
        if (BOTH(3)) GRID_BAR();
    }
    if (IN(4)) {
        DenseSched S; S.init(M, D, F.G, (int)blockIdx.x); S.A = (const char*)(F.ws + WS_YG); S.Bt = (const char*)(F.ws + WS_WUPB); S.a_tstep = (size_t)BM * SW * 2; S.b_tstep = (size_t)BM * SW * 2;
        EpiGate<2> E{(bf16*)(F.ws + WS_MG), (const bf16*)(F.ws + WS_T1), (const bf16*)(F.ws + WS_GB), nullptr, D};
        gemm_phase<EpiGate<2>, DenseSched, true, false>(ring, SW, SW, SW, S, E);
        if (BOTH(4)) GRID_BAR();
    }
    if (IN(5)) {
        DenseSched S; S.init(M, D, F.G, (int)blockIdx.x); S.A = (const char*)(F.ws + WS_MG); S.Bt = (const char*)(F.ws + WS_WO); S.a_tstep = (size_t)BM * D * 2; S.b_tstep = (size_t)BM * D * 2;
        EpiMix E{(float*)(F.ws + WS_MIX), (const bf16*)(F.ws + WS_XN)};
        gemm_phase<EpiMix, DenseSched, true, false>(ring, D, D, D, S, E);
        if (BOTH(5)) GRID_BAR();
    }
    if (IN(6)) { p6_ln1_router(F); if (BOTH(6)) GRID_BAR(); }

    if (IN(7)) {
        const int ntile = moe_tables(F);
        MoeSched S; S.tab = (const LAS int*)(F.lds + TAB_OFF); S.G = F.G; S.c = (int)blockIdx.x; S.npn = 8; S.total = ntile * 8;
        S.A = (const char*)(F.ws + WS_H1B); S.a_tstep = 0; S.Bt = (const char*)(F.ws + WS_WGU); S.b_estep = (size_t)2048 * D * 2; S.b_tstep = (size_t)BM * D * 2; S.list = (const int*)(F.ws + WS_LIST);
        EpiMoe1 E{(bf16*)(F.ws + WS_ACT), F.in[I_BG], F.in[I_BU]};
        gemm_phase<EpiMoe1, MoeSched, true, true>(ring, D, D, D, S, E);
        if (BOTH(7)) GRID_BAR();
    }
    if (IN(8)) {
        const int ntile = moe_tables(F);
        MoeSched S; S.tab = (const LAS int*)(F.lds + TAB_OFF); S.G = F.G; S.c = (int)blockIdx.x; S.npn = 4; S.total = ntile * 4;
        S.A = (const char*)(F.ws + WS_ACT); S.a_tstep = (size_t)BM * D * 2; S.Bt = (const char*)(F.ws + WS_WD); S.b_estep = (size_t)D * D * 2; S.b_tstep = (size_t)BM * D * 2; S.list = (const int*)(F.ws + WS_LIST);
        EpiMoe2 E{(bf16*)(F.ws + WS_YS), F.in[I_BD], (const int*)(F.ws + WS_LIST), (const float*)(F.ws + WS_WSLOT), (const LAS int*)(F.lds + TAB_OFF)};
        gemm_phase<EpiMoe2, MoeSched, true, false>(ring, D, D, D, S, E);
        if (BOTH(8)) GRID_BAR();
    }
    if (IN(9)) { p9_final(F); }
#undef IN
#undef BOTH
#undef GRID_BAR
}

extern "C" void kernel_launch(void* const* d_in, const int* in_sizes, int n_in, void* d_out, int out_size, void* d_ws, size_t ws_size, hipStream_t stream) {
    static int grid = 0;
    if (grid == 0) {
        if (n_in != 31 || in_sizes[0] != M * D || out_size != M * D || ws_size < WS_END) { fprintf(stderr, "kernel_launch: unexpected shapes / workspace (n_in %d, ws %zu, need %zu)\n", n_in, ws_size, (size_t)WS_END); grid = -1; return; }
        int dev = 0, cus = 0, per_cu = 0;
        if (hipGetDevice(&dev) != hipSuccess || hipDeviceGetAttribute(&cus, hipDeviceAttributeMultiprocessorCount, dev) != hipSuccess) { grid = -1; return; }
        if (hipFuncSetAttribute((const void*)fwd_kernel, hipFuncAttributeMaxDynamicSharedMemorySize, LDS_BYTES) != hipSuccess) { fprintf(stderr, "kernel_launch: hipFuncSetAttribute failed\n"); grid = -1; return; }
        if (hipOccupancyMaxActiveBlocksPerMultiprocessor(&per_cu, (const void*)fwd_kernel, NWAVES * 64, LDS_BYTES) != hipSuccess || per_cu < 1) fprintf(stderr, "kernel_launch: occupancy query reports %d\n", per_cu);
        (void)hipGetLastError();
        grid = cus;
        if (grid != 256) { fprintf(stderr, "kernel_launch: built for a 256-CU device, got %d\n", grid); grid = -1; return; }
    }
    if (grid < 0) return;
    if (hipMemsetAsync((char*)d_ws + WS_CTL, 0, CTL_ZERO_BYTES, stream) != hipSuccess) return;
    Args a{};
    for (int i = 0; i < 31; ++i) a.in[i] = (const float*)d_in[i];
    a.out = (float*)d_out; a.ws = (unsigned char*)d_ws; a.pad = 0;
    if (MK_N_LAUNCHES == 1) { a.ph_lo = 0; a.ph_hi = NPHASES; a.li = 0; hipLaunchKernelGGL(fwd_kernel, dim3(grid), dim3(NWAVES * 64), LDS_BYTES, stream, a); }
    else { for (int li = 0; li < NPHASES; ++li) { a.ph_lo = li; a.ph_hi = li + 1; a.li = li; hipLaunchKernelGGL(fwd_kernel, dim3(grid), dim3(NWAVES * 64), LDS_BYTES, stream, a); } }
}
```

```cpp
#include <hip/hip_runtime.h>
#include <cstdio>
#include <cstdint>

#define LAS __attribute__((address_space(3)))
#define GAS __attribute__((address_space(1)))
typedef unsigned short bf16;
typedef short bf16x8 __attribute__((ext_vector_type(8)));
typedef float f32x4 __attribute__((ext_vector_type(4)));
typedef float f32x2 __attribute__((ext_vector_type(2)));
typedef unsigned u32x4 __attribute__((ext_vector_type(4)));
typedef unsigned u32x2 __attribute__((ext_vector_type(2)));
typedef GAS unsigned gu32;

constexpr int NB = 2, SEQ = 8192, M = NB * SEQ, D = 1024, NMETA = 16, NH = 8, HD = 64, AW = 512, SW = 512, NG = 32, GC = 16, NP = 64, NE = 32, TOPK = 4;
constexpr int IN_COLS = 4104, F_OFF = 1536, U_OFF = 1544, GA_OFF = 2056, GB_OFF = 3080;
constexpr float LN_EPS = 1e-5f;
constexpr float ALPHA = 1.189207115002721f;
constexpr float LOG2E = 1.4426950408889634f;
constexpr float QSCALE = 0.125f * LOG2E;
constexpr float SW_LIMIT = 7.0f, SW_ALPHA = 1.702f;
constexpr int LIST_CAP = M;
constexpr int ACT_ROWS = 73728;

constexpr size_t MiB = 1u << 20;
constexpr size_t WS_CTL = 0, CTL_ZERO_BYTES = 1 * MiB;
constexpr size_t WS_WIN = 2 * MiB;
constexpr size_t WS_WUPA = 10 * MiB, WS_WUPB = 11 * MiB, WS_WO = 12 * MiB, WS_WGLU = 14 * MiB;
constexpr size_t WS_SMALL = 15 * MiB;
constexpr size_t WS_LOGF = 16 * MiB;
constexpr size_t WS_F2X = 17 * MiB;
constexpr size_t WS_LIST = 18 * MiB;
constexpr size_t WS_WSLOT = 20 * MiB;
constexpr size_t WS_WGU = 32 * MiB;
constexpr size_t WS_YS = 32 * MiB;
constexpr size_t WS_WD = 160 * MiB;
constexpr size_t WS_XN = 224 * MiB;
constexpr size_t WS_ACT = 224 * MiB;
constexpr size_t WS_Q = 256 * MiB, WS_K = 272 * MiB, WS_V = 288 * MiB;
constexpr size_t WS_U3 = 416 * MiB;
constexpr size_t WS_SS = 440 * MiB;
constexpr size_t WS_WY = 21 * MiB, WS_WSS = 27 * MiB;
constexpr size_t WS_MG = 256 * MiB;
constexpr size_t WS_GA = 320 * MiB, WS_GB = 352 * MiB;
constexpr size_t WS_YA = 384 * MiB, WS_YB = 400 * MiB, WS_YG = 416 * MiB, WS_T1 = 432 * MiB;
constexpr size_t WS_H1B = 368 * MiB;
constexpr size_t WS_MIX = 400 * MiB;
constexpr size_t WS_END = 464 * MiB;
constexpr size_t SM_KMETA = 0, SM_VMETA = 65536, SM_LOGFM = 131072, SM_UMETA = 135168, SM_F2M = 167936, SM_WRT = 262144;
constexpr int CW_TMO = 0, CW_CODE = 1;
constexpr int CW_CNT = 64;
constexpr int CW_QHEAD = 192;
constexpr int CW_BAR = 4096;

constexpr int RING_BYTES = 131072;
constexpr int LDSCTL_OFF = RING_BYTES, MISC_OFF = LDSCTL_OFF + 320, TAB_OFF = LDSCTL_OFF + 1024;
constexpr int LDS_BYTES = 147456;
constexpr int NWAVES = 8;

#ifndef MK_N_LAUNCHES
#define MK_N_LAUNCHES 1
#endif
constexpr int NPHASES = 10;
#ifndef PROBE_REPEAT
#define PROBE_REPEAT -1
#endif
#ifndef PROBE_STAMP
#define PROBE_STAMP -1
#endif
constexpr int CW_TS = 512;
#define REP(k) for (int rep_ = 0; rep_ < ((PROBE_REPEAT == (k)) ? 2 : 1); ++rep_)

#define RLX_AGENT __ATOMIC_RELAXED, __HIP_MEMORY_SCOPE_AGENT
#define LDS_WAIT() asm volatile("s_waitcnt lgkmcnt(0)" ::: "memory")
#define VM_WAIT() asm volatile("s_waitcnt vmcnt(0)" ::: "memory")
__device__ __forceinline__ unsigned f2bf(float f) { unsigned u = __builtin_bit_cast(unsigned, f); return (u + 0x7fffu + ((u >> 16) & 1u)) >> 16; }
__device__ __forceinline__ unsigned pk2(float lo, float hi) { return f2bf(lo) | (f2bf(hi) << 16); }
__device__ __forceinline__ unsigned cvt_pk_bf16(float lo, float hi) { unsigned r; asm volatile("v_cvt_pk_bf16_f32 %0, %1, %2" : "=v"(r) : "v"(lo), "v"(hi)); return r; }
__device__ __forceinline__ float bflo(unsigned u) { return __builtin_bit_cast(float, u << 16); }
__device__ __forceinline__ float bfhi(unsigned u) { return __builtin_bit_cast(float, u & 0xffff0000u); }
__device__ __forceinline__ float sigmoidf_(float x) { return __builtin_amdgcn_rcpf(1.0f + __builtin_amdgcn_exp2f(-x * LOG2E)); }
__device__ __forceinline__ int fresh_tid() { int t = threadIdx.x; asm volatile("" : "+v"(t)); return t; }
__device__ __forceinline__ float wave_sum(float v) {
#pragma unroll
    for (int o = 1; o < 64; o <<= 1) v += __shfl_xor(v, o);
    return v;
}
__device__ __forceinline__ float log_sigmoidf_(float x) { const float y = __expf(-fabsf(x)); return fminf(x, 0.f) - __logf(1.0f + y); }
__device__ __forceinline__ float gelu_tanh(float x) {
    const float z = 0.7978845608028654f * (x + 0.044715f * x * x * x);
    return x * sigmoidf_(2.0f * z);
}
__device__ __forceinline__ void sincos_acc(float x, float& s, float& c) {
    const float kf = rintf(x * 0.6366197723675814f); const int k = (int)kf;
    float r = fmaf(-kf, 1.5703125f, x); r = fmaf(-kf, 4.837512969970703125e-4f, r); r = fmaf(-kf, 7.54978995489188216e-8f, r);
    const float r2 = r * r;
    const float sp = r + r * r2 * (-1.6666654611e-1f + r2 * (8.3321608736e-3f + r2 * (-1.9515295891e-4f)));
    const float cp = 1.0f - 0.5f * r2 + r2 * r2 * (4.166664568298827e-2f + r2 * (-1.388731625493765e-3f + r2 * 2.443315711809948e-5f));
    const int q = k & 3;
    s = (q == 0) ? sp : (q == 1) ? cp : (q == 2) ? -sp : -cp;
    c = (q == 0) ? cp : (q == 1) ? -sp : (q == 2) ? -cp : sp;
}

namespace pg8 {
constexpr int BM = 256, BK = 64, HALF = 128, HTB = HALF * BK * 2, STAGE_BYTES = 8 * HTB, NXCD = 8, WGM = 8;
__host__ __device__ __forceinline__ int lds_byte(int r, int c) { const int st = (r >> 4) * 2 + (c >> 5), rr = r & 15, cc = c & 31, ob = rr * 64 + cc * 2; return st * 1024 + (ob ^ (((ob >> 9) & 1) << 5)); }
__host__ __device__ __forceinline__ void stage_rc(int b, int& R, int& C) { const int st = b / 1024, sb = b % 1024, swz = sb ^ (((sb >> 9) & 1) << 5); R = (st >> 1) * 16 + swz / 64; C = (st & 1) * 32 + (swz % 64) / 2; }
__host__ __device__ __forceinline__ int perm32(int rho) { const int n = rho >> 4, i = rho & 15; return 8 * (i >> 2) + 4 * n + (i & 3); }

struct Unit { int pm, pn, e, mt; };

struct StaticOrder {
    int nM, nN, nwg, G, c;
    __device__ void init(int M_, int N_, int G_, int c_) { nM = M_ / BM; nN = N_ / BM; nwg = nM * nN; G = G_; c = c_; }
    __device__ bool next(int i, Unit& u) const {
        const long L = (long)i * G + c; if (L >= nwg) return false;
        int wgid = (int)L; { const int q = nwg / NXCD, r = nwg % NXCD, xcd = wgid % NXCD, off = wgid / NXCD; wgid = (xcd < r ? xcd * (q + 1) : r * (q + 1) + (xcd - r) * q) + off; }
        const int nig = WGM * nN, gid = wgid / nig, fm = gid * WGM, gsz = (nM - fm) < WGM ? (nM - fm) : WGM;
        u.pm = fm + ((wgid % nig) % gsz); u.pn = (wgid % nig) / gsz; u.e = 0; u.mt = 0; return true;
    }
};
struct DenseSched : StaticOrder {
    const char* A; const char* Bt; size_t a_tstep, b_tstep;
    __device__ __forceinline__ const char* a_base(const Unit& u) const { return A + (size_t)u.pm * a_tstep; }
    __device__ __forceinline__ const char* b_base(const Unit& u) const { return Bt + (size_t)u.pn * b_tstep; }
    __device__ __forceinline__ unsigned a_row_off(const Unit&, int) const { return 0u; }
};

template <class Epi, class Sched, bool ALIGN_EPI, bool GATHER>
__device__ __forceinline__ void gemm_phase(LAS unsigned char* lds, const int K, const int lda, const int ldb, const Sched& S, const Epi& E) {
    const int tid = fresh_tid(), wid = __builtin_amdgcn_readfirstlane(tid >> 6), lane = tid & 63, wr = wid >> 2, wc = wid & 3, fr = lane & 15, fq = lane >> 4;
    const int nt = K / BK;
    unsigned voffA[2][2], nvoffA[2][2], voffB[2]; int RA[2], CA[2];
#pragma unroll
    for (int i = 0; i < 2; ++i) { int R, C; stage_rc(tid * 16 + i * 8192, R, C); const int Rb = Epi::PERM ? ((R & ~31) + perm32(R & 31)) : R;
        RA[i] = R; CA[i] = C; voffB[i] = (unsigned)(Rb * ldb + C) * 2u;
        voffA[0][i] = (unsigned)(R * lda + C) * 2u; voffA[1][i] = (unsigned)((R + HALF) * lda + C) * 2u; nvoffA[0][i] = voffA[0][i]; nvoffA[1][i] = voffA[1][i]; }
    const size_t kstep = (size_t)(BK * 2);
    const size_t hstepB = (size_t)HALF * ldb * 2;
    const unsigned ldsw = (unsigned)wid * 1024u;
    const int aoff = lds_byte(wr * 64 + fr, fq * 8), boff = lds_byte(wc * 32 + fr, fq * 8);
#define PG8_SA(b, h) (((b) * 2 + (h)) * HTB)
#define PG8_SB(b, h) ((4 + (b) * 2 + (h)) * HTB)
#define PG8_STAGE2(bufoff, gbase, v0, v1) do { \
        __builtin_amdgcn_global_load_lds((const unsigned*)((const char*)(gbase) + (v0)), (LAS unsigned*)(lds + (bufoff) + ldsw), 16, 0, 0); \
        __builtin_amdgcn_global_load_lds((const unsigned*)((const char*)(gbase) + (v1)), (LAS unsigned*)(lds + (bufoff) + ldsw + 8192), 16, 0, 0); } while (0)
#define PG8_STAGEB(bufoff, gbase) PG8_STAGE2(bufoff, gbase, voffB[0], voffB[1])
#define PG8_LDA(dst, b, h) do { _Pragma("unroll") for (int m = 0; m < 4; ++m) _Pragma("unroll") for (int k = 0; k < 2; ++k) dst[m][k] = *(const LAS bf16x8*)(lds + PG8_SA(b, h) + aoff + m * 2048 + k * 1024); } while (0)
#define PG8_LDB(dst, b, h) do { _Pragma("unroll") for (int n = 0; n < 2; ++n) _Pragma("unroll") for (int k = 0; k < 2; ++k) dst[n][k] = *(const LAS bf16x8*)(lds + PG8_SB(b, h) + boff + n * 2048 + k * 1024); } while (0)
#define PG8_MMA(ai, bj, At, Bt) do { __builtin_amdgcn_s_setprio(1); _Pragma("unroll") for (int m = 0; m < 4; ++m) _Pragma("unroll") for (int n = 0; n < 2; ++n) _Pragma("unroll") for (int k = 0; k < 2; ++k) \
        acc[ai][bj][m][n] = __builtin_amdgcn_mfma_f32_16x16x32_bf16(Bt[n][k], At[m][k], acc[ai][bj][m][n], 0, 0, 0); __builtin_amdgcn_s_setprio(0); } while (0)
#define PG8_WAIT_V(n) asm volatile("s_waitcnt vmcnt(" #n ")" ::: "memory")
#define PG8_WAIT_L(n) asm volatile("s_waitcnt lgkmcnt(" #n ")" ::: "memory")
#define PG8_BAR __builtin_amdgcn_s_barrier()
#define PG8_SCHED __builtin_amdgcn_sched_barrier(0)
    Unit cur, nxt; int ui = 0;
    if (!S.next(0, cur)) return;
    f32x4 acc[2][2][4][2];
#pragma unroll
    for (int a = 0; a < 2; ++a)
#pragma unroll
        for (int b = 0; b < 2; ++b)
#pragma unroll
            for (int m = 0; m < 4; ++m)
#pragma unroll
                for (int n = 0; n < 2; ++n) acc[a][b][m][n] = (f32x4){0.f, 0.f, 0.f, 0.f};
    bf16x8 At[4][2], B0[2][2], B1[2][2];
    const char* cA = S.a_base(cur); const char* cB = S.b_base(cur);
    if constexpr (GATHER) {
#pragma unroll
        for (int h = 0; h < 2; ++h)
#pragma unroll
            for (int i = 0; i < 2; ++i) voffA[h][i] = S.a_row_off(cur, h * HALF + RA[i]) + (unsigned)CA[i] * 2u;
        PG8_WAIT_V(0);
    }
    PG8_STAGEB(PG8_SB(0, 0), cB); PG8_STAGEB(PG8_SB(0, 1), cB + hstepB); PG8_STAGE2(PG8_SA(0, 0), cA, voffA[0][0], voffA[0][1]); PG8_STAGE2(PG8_SA(0, 1), cA, voffA[1][0], voffA[1][1]);
    if (wr == 1) PG8_BAR;
    PG8_WAIT_V(2); PG8_BAR;
    PG8_STAGEB(PG8_SB(1, 0), cB + kstep); PG8_STAGE2(PG8_SA(1, 0), cA + kstep, voffA[0][0], voffA[0][1]); PG8_STAGEB(PG8_SB(1, 1), cB + hstepB + kstep);
    PG8_WAIT_V(6); PG8_BAR;
    for (;;) {
        const bool has_next = S.next(ui + 1, nxt);
        const char* nA = has_next ? S.a_base(nxt) : cA; const char* nB = has_next ? S.b_base(nxt) : cB;
        if constexpr (GATHER) {
            if (has_next) {
#pragma unroll
                for (int h = 0; h < 2; ++h)
#pragma unroll
                    for (int i = 0; i < 2; ++i) nvoffA[h][i] = S.a_row_off(nxt, h * HALF + RA[i]) + (unsigned)CA[i] * 2u;
                PG8_WAIT_V(0);
            } else {
#pragma unroll
                for (int h = 0; h < 2; ++h)
#pragma unroll
                    for (int i = 0; i < 2; ++i) nvoffA[h][i] = voffA[h][i];
            }
        }
        for (int t = 0; t < nt; t += 2) {
            const bool last = (t == nt - 2);
            const char* a1 = cA + (size_t)(t + 1) * kstep;
            const char* a2 = last ? nA : cA + (size_t)(t + 2) * kstep; const char* b2 = last ? nB : cB + (size_t)(t + 2) * kstep;
            const char* a3 = a2 + kstep; const char* b3 = b2 + kstep;
            unsigned w00, w01, w10, w11;
            if constexpr (GATHER) { w00 = last ? nvoffA[0][0] : voffA[0][0]; w01 = last ? nvoffA[0][1] : voffA[0][1]; w10 = last ? nvoffA[1][0] : voffA[1][0]; w11 = last ? nvoffA[1][1] : voffA[1][1]; }
            else { w00 = voffA[0][0]; w01 = voffA[0][1]; w10 = voffA[1][0]; w11 = voffA[1][1]; }
            PG8_LDB(B0, 0, 0); PG8_LDB(B1, 0, 1); PG8_SCHED; PG8_LDA(At, 0, 0); PG8_STAGE2(PG8_SA(1, 1), a1, voffA[1][0], voffA[1][1]);
            PG8_WAIT_V(8); PG8_WAIT_L(0); PG8_BAR; PG8_MMA(0, 0, At, B0); PG8_MMA(0, 1, At, B1); PG8_BAR; PG8_SCHED;
            PG8_LDA(At, 0, 1); PG8_STAGEB(PG8_SB(0, 0), b2); PG8_STAGEB(PG8_SB(0, 1), b2 + hstepB); PG8_STAGE2(PG8_SA(0, 0), a2, w00, w01);
            PG8_WAIT_V(8); PG8_WAIT_L(0); PG8_BAR; PG8_MMA(1, 0, At, B0); PG8_MMA(1, 1, At, B1); PG8_BAR; PG8_SCHED;
            PG8_LDB(B0, 1, 0); PG8_LDB(B1, 1, 1); PG8_SCHED; PG8_LDA(At, 1, 0); PG8_STAGE2(PG8_SA(0, 1), a2, w10, w11);
            PG8_WAIT_V(8); PG8_WAIT_L(0); PG8_BAR; PG8_MMA(0, 0, At, B0); PG8_MMA(0, 1, At, B1); PG8_BAR; PG8_SCHED;
            PG8_LDA(At, 1, 1); PG8_STAGEB(PG8_SB(1, 0), b3); PG8_STAGEB(PG8_SB(1, 1), b3 + hstepB); PG8_STAGE2(PG8_SA(1, 0), a3, w00, w01);
            PG8_WAIT_V(8); PG8_WAIT_L(0); PG8_BAR; PG8_MMA(1, 0, At, B0); PG8_MMA(1, 1, At, B1); PG8_BAR; PG8_SCHED;
        }
        if constexpr (ALIGN_EPI) { if (wr == 0) PG8_BAR; }
        E(acc, cur, wr, wc, fr, fq);
        if (!has_next) break;
#pragma unroll
        for (int a = 0; a < 2; ++a)
#pragma unroll
            for (int b = 0; b < 2; ++b)
#pragma unroll
                for (int m = 0; m < 4; ++m)
#pragma unroll
                    for (int n = 0; n < 2; ++n) acc[a][b][m][n] = (f32x4){0.f, 0.f, 0.f, 0.f};
        cur = nxt; cA = nA; cB = nB; ++ui;
        if constexpr (GATHER) {
#pragma unroll
            for (int h = 0; h < 2; ++h)
#pragma unroll
                for (int i = 0; i < 2; ++i) voffA[h][i] = nvoffA[h][i];
        }
        if constexpr (ALIGN_EPI) { if (wr == 1) PG8_BAR; }
    }
    PG8_WAIT_V(0);
    if constexpr (!ALIGN_EPI) { if (wr == 0) PG8_BAR; }
    PG8_BAR;
#undef PG8_SA
#undef PG8_SB
#undef PG8_STAGE2
#undef PG8_STAGEB
#undef PG8_LDA
#undef PG8_LDB
#undef PG8_MMA
#undef PG8_WAIT_V
#undef PG8_WAIT_L
#undef PG8_BAR
#undef PG8_SCHED
}

typedef f32x4 Acc[2][2][4][2];
__device__ __forceinline__ u32x4 pack8(f32x4 v0, f32x4 v1) { u32x4 w; w.x = cvt_pk_bf16(v0[0], v0[1]); w.y = cvt_pk_bf16(v0[2], v0[3]); w.z = cvt_pk_bf16(v1[0], v1[1]); w.w = cvt_pk_bf16(v1[2], v1[3]); return w; }
__device__ __forceinline__ void unpack8(u32x4 w, f32x4& v0, f32x4& v1) { v0 = (f32x4){bflo(w.x), bfhi(w.x), bflo(w.y), bfhi(w.y)}; v1 = (f32x4){bflo(w.z), bfhi(w.z), bflo(w.w), bfhi(w.w)}; }
__device__ __forceinline__ f32x4 sig4(f32x4 v) { return (f32x4){sigmoidf_(v[0]), sigmoidf_(v[1]), sigmoidf_(v[2]), sigmoidf_(v[3])}; }

struct EpiInProj {
    static constexpr bool PERM = true;
    bf16 *Q, *Kk, *V, *U, *GA, *GB;
    __device__ __forceinline__ void operator()(const Acc& acc, const Unit& u, int wr, int wc, int fr, int fq) const {
        const int pn = u.pn, row0 = u.pm * BM + wr * 64 + fr, ct = wc * 32 + 8 * fq;
        bf16* base; int ldc, colb, mode;
        if (pn < 2) { base = Q; ldc = AW; colb = pn * 256; mode = 1; }
        else if (pn < 4) { base = Kk; ldc = AW; colb = (pn - 2) * 256; mode = 0; }
        else if (pn < 6) { base = V; ldc = AW; colb = (pn - 4) * 256; mode = 0; }
        else if (pn < 8) { base = U; ldc = 0; colb = (pn - 6) * 256; mode = 3; }
        else if (pn < 12) { base = GA; ldc = D; colb = (pn - 8) * 256; mode = 2; }
        else { base = GB; ldc = D; colb = (pn - 12) * 256; mode = 2; }
#pragma unroll
        for (int ai = 0; ai < 2; ++ai)
#pragma unroll
            for (int m = 0; m < 4; ++m) { const int row = row0 + ai * HALF + m * 16;
#pragma unroll
                for (int bj = 0; bj < 2; ++bj) { f32x4 v0 = acc[ai][bj][m][0], v1 = acc[ai][bj][m][1]; const int col = colb + bj * HALF + ct;
                    if (mode == 1) { v0 = v0 * QSCALE; v1 = v1 * QSCALE; }
                    if (mode == 2) { v0 = sig4(v0); v1 = sig4(v1); }
                    bf16* p = (mode == 3) ? base + ((size_t)(col >> 4) * 1024 + (row >> 4)) * 384 + (row & 15) * 16 + (col & 15) : base + (size_t)row * ldc + col;
                    *(u32x4*)p = pack8(v0, v1); } }
    }
};
template <int MODE> struct EpiGate {
    static constexpr bool PERM = true;
    bf16* O; const bf16* X; const bf16* G; const float* bias; int ldc;
    __device__ __forceinline__ void operator()(const Acc& acc, const Unit& u, int wr, int wc, int fr, int fq) const {
        const int row0 = u.pm * BM + wr * 64 + fr, col0 = u.pn * BM + wc * 32 + 8 * fq;
#pragma unroll
        for (int ai = 0; ai < 2; ++ai)
#pragma unroll
            for (int m = 0; m < 4; ++m) { const size_t ro = (size_t)(row0 + ai * HALF + m * 16) * ldc;
#pragma unroll
                for (int bj = 0; bj < 2; ++bj) { f32x4 v0 = acc[ai][bj][m][0], v1 = acc[ai][bj][m][1]; const int col = col0 + bj * HALF; f32x4 x0, x1, g0, g1;
                    if (MODE == 0) { const f32x4 b0 = *(const f32x4*)(bias + col), b1 = *(const f32x4*)(bias + col + 4); unpack8(*(const u32x4*)(X + ro + col), x0, x1); v0 = x0 * sig4(v0 + b0); v1 = x1 * sig4(v1 + b1); }
                    if (MODE == 1) { unpack8(*(const u32x4*)(G + ro + col), g0, g1); v0 = v0 * g0; v1 = v1 * g1; }
                    if (MODE == 2) { unpack8(*(const u32x4*)(G + ro + col), g0, g1); unpack8(*(const u32x4*)(X + ro + col), x0, x1); v0 = x0 + v0 * g0; v1 = x1 + v1 * g1; }
                    *(u32x4*)(O + ro + col) = pack8(v0, v1); } }
    }
};
struct EpiMix {
    static constexpr bool PERM = false;
    float* O; const bf16* XN;
    __device__ __forceinline__ void operator()(const Acc& acc, const Unit& u, int wr, int wc, int fr, int fq) const {
        const int row0 = u.pm * BM + wr * 64 + fr, col0 = u.pn * BM + wc * 32 + 4 * fq;
#pragma unroll
        for (int ai = 0; ai < 2; ++ai)
#pragma unroll
            for (int m = 0; m < 4; ++m) { const size_t ro = (size_t)(row0 + ai * HALF + m * 16) * D;
#pragma unroll
                for (int bj = 0; bj < 2; ++bj)
#pragma unroll
                    for (int n = 0; n < 2; ++n) { const int col = col0 + bj * HALF + n * 16; const u32x2 h = *(const u32x2*)(XN + ro + col);
                        const f32x4 hv = (f32x4){bflo(h.x), bfhi(h.x), bflo(h.y), bfhi(h.y)};
                        *(f32x4*)(O + ro + col) = hv * ALPHA + acc[ai][bj][m][n]; } }
    }
};
struct EpiMoe1 {
    static constexpr bool PERM = true;
    bf16* ACT; const float* bg; const float* bu;
    __device__ __forceinline__ void operator()(const Acc& acc, const Unit& u, int wr, int wc, int fr, int fq) const {
        const int row0 = u.pm * BM + wr * 64 + fr, col = u.pn * HALF + wc * 32 + 8 * fq;
        const float* pg = bg + (size_t)u.e * D + col; const float* pu = bu + (size_t)u.e * D + col;
        const f32x4 g0 = *(const f32x4*)pg, g1 = *(const f32x4*)(pg + 4), u0 = *(const f32x4*)pu, u1 = *(const f32x4*)(pu + 4);
#pragma unroll
        for (int ai = 0; ai < 2; ++ai)
#pragma unroll
            for (int m = 0; m < 4; ++m) { const size_t ro = (size_t)(row0 + ai * HALF + m * 16) * D;
                f32x4 ga = acc[ai][0][m][0] + g0, gb = acc[ai][0][m][1] + g1, ua = acc[ai][1][m][0] + u0, ub = acc[ai][1][m][1] + u1;
#pragma unroll
                for (int i = 0; i < 4; ++i) { const float g_ = fminf(ga[i], SW_LIMIT), u_ = fminf(fmaxf(ua[i], -SW_LIMIT), SW_LIMIT); ga[i] = (u_ + 1.0f) * g_ * sigmoidf_(SW_ALPHA * g_);
                    const float g2 = fminf(gb[i], SW_LIMIT), u2 = fminf(fmaxf(ub[i], -SW_LIMIT), SW_LIMIT); gb[i] = (u2 + 1.0f) * g2 * sigmoidf_(SW_ALPHA * g2); }
                *(u32x4*)(ACT + ro + col) = pack8(ga, gb); }
    }
};
struct EpiMoe2 {
    static constexpr bool PERM = true;
    bf16* YS; const float* bd; const int* list; const float* wslot; const LAS int* tab;
    __device__ __forceinline__ void operator()(const Acc& acc, const Unit& u, int wr, int wc, int fr, int fq) const {
        const int r0 = wr * 64 + fr, col0 = u.pn * BM + wc * 32 + 8 * fq, cnt = tab[40 + u.e];
        const float* pb = bd + (size_t)u.e * D + col0;
        f32x4 b[2][2];
#pragma unroll
        for (int bj = 0; bj < 2; ++bj) { b[bj][0] = *(const f32x4*)(pb + bj * HALF); b[bj][1] = *(const f32x4*)(pb + bj * HALF + 4); }
#pragma unroll
        for (int ai = 0; ai < 2; ++ai)
#pragma unroll
            for (int m = 0; m < 4; ++m) { const int rr = u.mt * BM + r0 + ai * HALF + m * 16;
                if (rr < cnt) { const int slot = list[(size_t)u.e * LIST_CAP + rr]; const float w = wslot[slot];
#pragma unroll
                    for (int bj = 0; bj < 2; ++bj) { const f32x4 v0 = (acc[ai][bj][m][0] + b[bj][0]) * w, v1 = (acc[ai][bj][m][1] + b[bj][1]) * w;
                        *(u32x4*)(YS + (size_t)slot * D + col0 + bj * HALF) = pack8(v0, v1); } } }
    }
};
struct MoeSched {
    const LAS int* tab; int G, c, npn, total;
    const char* A; const char* Bt; size_t a_tstep, b_estep, b_tstep; const int* list;
    __device__ __forceinline__ bool next(int i, Unit& u) const {
        const int x = c & 7, r = c >> 3, uu = i * (G >> 3) + r, mtl = uu / npn; const int tau = 8 * mtl + x; if (tau * npn >= total) return false;
        u.pn = uu - mtl * npn; int e = 0;
        for (int j = 1; j < NE; ++j) if (tab[j] <= tau) e = j;
        u.e = e; u.pm = tau; u.mt = tau - tab[e]; return true;
    }
    __device__ __forceinline__ const char* a_base(const Unit& u) const { return A + (size_t)u.pm * a_tstep; }
    __device__ __forceinline__ const char* b_base(const Unit& u) const { return Bt + (size_t)u.e * b_estep + (size_t)u.pn * b_tstep; }
    __device__ __forceinline__ unsigned a_row_off(const Unit& u, int r) const {
        const int rr = u.mt * BM + r; const int cnt = tab[40 + u.e]; int tok = 0;
        if (rr < cnt) tok = list[(size_t)u.e * LIST_CAP + rr] >> 2;
        return (unsigned)tok * (unsigned)(D * 2);
    }
};
struct SsmSched { const char* A; const char* Bt; size_t a_tstep; int pm0, g;
    __device__ __forceinline__ bool next(int i, Unit& u) const { if (i >= 2) return false; u.pm = pm0 + i; u.pn = 0; u.e = g; u.mt = 0; return true; }
    __device__ __forceinline__ const char* a_base(const Unit& u) const { return A + (size_t)u.pm * a_tstep; }
    __device__ __forceinline__ const char* b_base(const Unit&) const { return Bt; }
    __device__ __forceinline__ unsigned a_row_off(const Unit&, int) const { return 0u; }
};
struct EpiS {
    static constexpr bool PERM = false;
    float* SS;
    __device__ __forceinline__ void operator()(const Acc& acc, const Unit& u, int wr, int wc, int fr, int fq) const {
        const int row0 = u.pm * BM + wr * 64 + fr, col0 = wc * 32 + 4 * fq;
#pragma unroll
        for (int ai = 0; ai < 2; ++ai)
#pragma unroll
            for (int m = 0; m < 4; ++m) { float* rp = SS + ((size_t)u.e * 1024 + row0 + ai * HALF + m * 16) * 128 + col0;
#pragma unroll
                for (int n = 0; n < 2; ++n) *(f32x4*)(rp + n * 16) = acc[ai][0][m][n]; }
    }
};
struct EpiY {
    static constexpr bool PERM = true;
    bf16* Yb;
    __device__ __forceinline__ void operator()(const Acc& acc, const Unit& u, int wr, int wc, int fr, int fq) const {
        const int row0 = u.pm * BM + wr * 64 + fr;
#pragma unroll
        for (int ai = 0; ai < 2; ++ai)
#pragma unroll
            for (int m = 0; m < 4; ++m) { const int r = row0 + ai * HALF + m * 16;
#pragma unroll
                for (int bj = 0; bj < 2; ++bj) { const int n0 = bj * HALF + wc * 32 + 8 * fq, jp = n0 >> 4, c0 = n0 & 15; f32x4 v0 = acc[ai][bj][m][0], v1 = acc[ai][bj][m][1];
#pragma unroll
                    for (int i = 0; i < 4; ++i) { v0[i] = gelu_tanh(v0[i]); v1[i] = gelu_tanh(v1[i]); }
                    *(u32x4*)(Yb + ((size_t)r * 16 + jp) * SW + u.e * GC + c0) = pack8(v0, v1); } }
    }
};
}

#include <hip/hip_bf16.h>
#include <cmath>
namespace attn_body {
using bf16=__hip_bfloat16;
typedef float f32x4_t __attribute__((ext_vector_type(4)));
using bf16x8=__attribute__((ext_vector_type(8)))short;
using s16x4=__attribute__((ext_vector_type(4)))short;
using f32x16=__attribute__((ext_vector_type(16)))float;
using u32x4=__attribute__((ext_vector_type(4)))unsigned;
constexpr int BATCH=2,NHEAD=8,SEQ=8192,D=64,DM=NHEAD*D;
constexpr int NW=8,QBLK=32,QB=QBLK*NW,KVBLK=64,NQB=SEQ/QB;
constexpr int ATTN_PITCH=DM, ATTN_UNIT_ROWS=QB;
__device__ __forceinline__ int crow(int r,int hi){return (r&3)+8*(r>>2)+4*hi;}
#define SBAR() __builtin_amdgcn_sched_barrier(0)
__device__ __forceinline__ void cmask(f32x16&p0,f32x16&p1,int jb,int qrel,int hi){
  const float NEG=-INFINITY; int kb=64*jb+4*hi;
  #pragma unroll
  for(int r=0;r<16;++r){int kv=kb+(r&3)+8*(r>>2); if(kv>qrel)p0[r]=NEG; if(kv+32>qrel)p1[r]=NEG;}
}

constexpr int NSLOT=3, SLOTB=8192;
constexpr int LDS_K=0, LDS_V=NSLOT*SLOTB, LDS_WS=2*NSLOT*SLOTB, LDS_OST=LDS_WS+NW*64*4, LDS_F=LDS_OST+NW*4096, LDS_BYTES=LDS_F+NSLOT*256;
constexpr float C2=0.125f*1.4426950408889634f;
__device__ __forceinline__ void glds16(const void*gsrc,unsigned lds_dst){unsigned keep;
  asm volatile("s_mov_b32 %0, m0\n\ts_mov_b32 m0, %2\n\ts_nop 0\n\tglobal_load_lds_dwordx4 %1, off\n\ts_mov_b32 m0, %0":"=&s"(keep):"v"(gsrc),"s"(lds_dst):"memory");}
__device__ __forceinline__ void glds4(const void*gsrc,unsigned lds_dst){unsigned keep;
  asm volatile("s_mov_b32 %0, m0\n\ts_mov_b32 m0, %2\n\ts_nop 0\n\tglobal_load_lds_dword %1, off\n\ts_mov_b32 m0, %0":"=&s"(keep):"v"(gsrc),"s"(lds_dst):"memory");}
__device__ __forceinline__ float max3f(float a,float b,float c){float r;asm("v_max3_f32 %0, %1, %2, %3":"=v"(r):"v"(a),"v"(b),"v"(c));return r;}
__device__ __forceinline__ float max2f(float a,float b){float r;asm("v_max_f32_e32 %0, %1, %2":"=v"(r):"v"(a),"v"(b));return r;}
__device__ __forceinline__ float fadd_s(float a,float b){float r;asm("v_add_f32_e32 %0, %1, %2":"=v"(r):"v"(a),"v"(b));return r;}
__device__ __forceinline__ float fsub_s(float a,float b){float r;asm("v_sub_f32_e32 %0, %1, %2":"=v"(r):"v"(a),"v"(b));return r;}
typedef float f32x2_t __attribute__((ext_vector_type(2))); typedef __bf16 bf16x2_t __attribute__((ext_vector_type(2)));
__device__ __forceinline__ unsigned cvtpk_s(float lo,float hi){f32x2_t v={lo,hi};bf16x2_t b=__builtin_convertvector(v,bf16x2_t);return __builtin_bit_cast(unsigned,b);}
#define WAIT_BAR(N) asm volatile("s_waitcnt vmcnt(" #N ") lgkmcnt(0)\n\ts_barrier":::"memory")

__device__ __forceinline__ void qkt(f32x16&p0,f32x16&p1,const char*Kslot,const bf16x8*qr,int r32,int hi){
  const char*kb=Kslot+hi*1024+r32*16;
  #pragma unroll
  for(int d0=0;d0<4;++d0){
    const bf16x8 b0=*reinterpret_cast<const bf16x8*>(kb+d0*2048);
    const bf16x8 b1=*reinterpret_cast<const bf16x8*>(kb+d0*2048+512);
    p0=__builtin_amdgcn_mfma_f32_32x32x16_bf16(b0,qr[d0],p0,0,0,0);p1=__builtin_amdgcn_mfma_f32_32x32x16_bf16(b1,qr[d0],p1,0,0,0);}
}
typedef __attribute__((address_space(3))) const char* lds_cptr;
typedef short v4i16_t __attribute__((ext_vector_type(4)));
__device__ __forceinline__ void kload8(bf16x8*kf,lds_cptr kp){
  kf[0]=*(const __attribute__((address_space(3))) bf16x8*)(kp);      kf[1]=*(const __attribute__((address_space(3))) bf16x8*)(kp+512);
  kf[2]=*(const __attribute__((address_space(3))) bf16x8*)(kp+2048); kf[3]=*(const __attribute__((address_space(3))) bf16x8*)(kp+2560);
  kf[4]=*(const __attribute__((address_space(3))) bf16x8*)(kp+4096); kf[5]=*(const __attribute__((address_space(3))) bf16x8*)(kp+4608);
  kf[6]=*(const __attribute__((address_space(3))) bf16x8*)(kp+6144); kf[7]=*(const __attribute__((address_space(3))) bf16x8*)(kp+6656);
}
__device__ __forceinline__ void kload2(bf16x8*kf,lds_cptr kp,int j){ kf[2*j]=*(const __attribute__((address_space(3))) bf16x8*)(kp+j*2048); kf[2*j+1]=*(const __attribute__((address_space(3))) bf16x8*)(kp+j*2048+512); }
__device__ __forceinline__ s16x4 vtr(lds_cptr p){ return __builtin_bit_cast(s16x4,__builtin_amdgcn_ds_read_tr16_b64_v4i16((__attribute__((address_space(3))) v4i16_t*)p)); }
__device__ __forceinline__ float rowmax(const f32x16&p0,const f32x16&p1){
  float a=max3f(p0[0],p0[1],p1[0]),b=max3f(p0[2],p0[3],p1[1]);a=max3f(a,p1[2],p1[3]);
  #pragma unroll
  for(int r=4;r<16;r+=4){a=max3f(a,p0[r],p0[r+1]);b=max3f(b,p0[r+2],p0[r+3]);a=max3f(a,p1[r],p1[r+1]);b=max3f(b,p1[r+2],p1[r+3]);}
  const float m=max2f(a,b);
  auto rr=__builtin_amdgcn_permlane32_swap(__float_as_uint(m),__float_as_uint(m),false,false);
  return max2f(__uint_as_float(rr[0]),__uint_as_float(rr[1]));
}
__device__ __forceinline__ void pv(f32x16*o,int vb,bf16x8 pa0,bf16x8 pa1,bf16x8 pa2,bf16x8 pa3){
  #pragma unroll
  for(int d0=0;d0<2;++d0){s16x4 lo[4],hi[4];
    #pragma unroll
    for(int ks=0;ks<4;++ks){
      asm volatile("ds_read_b64_tr_b16 %0,%1 offset:%c2":"=&v"(lo[ks]):"v"(vb),"i"(d0*4096+ks*1024):"memory");
      asm volatile("ds_read_b64_tr_b16 %0,%1 offset:%c2":"=&v"(hi[ks]):"v"(vb),"i"(d0*4096+ks*1024+512):"memory");}
    asm volatile("s_waitcnt lgkmcnt(0)":::"memory");SBAR();
    #define PK(k) (bf16x8){lo[k][0],lo[k][1],lo[k][2],lo[k][3],hi[k][0],hi[k][1],hi[k][2],hi[k][3]}
    o[d0]=__builtin_amdgcn_mfma_f32_32x32x16_bf16(pa0,PK(0),o[d0],0,0,0);
    o[d0]=__builtin_amdgcn_mfma_f32_32x32x16_bf16(pa1,PK(1),o[d0],0,0,0);
    o[d0]=__builtin_amdgcn_mfma_f32_32x32x16_bf16(pa2,PK(2),o[d0],0,0,0);
    o[d0]=__builtin_amdgcn_mfma_f32_32x32x16_bf16(pa3,PK(3),o[d0],0,0,0);
    #undef PK
  }
}

#ifndef ATTN_STORE16
#define ATTN_STORE16(p,v) (*(u32x4*)(p)=(v))
#endif
template<int THRL> __device__ __forceinline__ void attn_unit(int b,int h,int qb,const bf16*Q,const bf16*__restrict__ K,const bf16*__restrict__ V,const bf16*__restrict__ KM,const bf16*__restrict__ VM,const float*__restrict__ F2x,const float*__restrict__ F2m,bf16*O,char*shm){
  int tid=threadIdx.x; asm volatile("":"+v"(tid)); const int lane=tid&63,r32=lane&31,hi=lane>>5; const int wid=__builtin_amdgcn_readfirstlane(tid>>6);
  const long rowbase=(long)b*SEQ; const int q0=qb*QB;
  const bf16*Qw=Q+(rowbase+q0+wid*QBLK)*DM+h*D;
  const bf16*Kh=K+rowbase*DM+h*D,*Vh=V+rowbase*DM+h*D;
  const unsigned lds0=(unsigned)(uintptr_t)shm;
  float*wsf=(float*)(shm+LDS_WS)+wid*64;
  const float*Fh=F2x+(long)(b*NHEAD+h)*SEQ;
  const bf16*ksrc=Kh+(long)lane*DM+wid*8-(long)KVBLK*DM;
  const bf16*vsrc=Vh+(long)(16*(wid&3)+(lane>>2))*DM+(wid>>2)*32+(lane&3)*8-(long)KVBLK*DM;
  const float*fsrc=Fh+lane-KVBLK;
  const bf16*ksrcm=KM+(long)lane*DM+h*D+wid*8;
  const bf16*vsrcm=VM+(long)(16*(wid&3)+(lane>>2))*DM+h*D+(wid>>2)*32+(lane&3)*8;
  const float*fsrcm=F2m+h*64+lane;
  const unsigned kdst=lds0+LDS_K+wid*1024, vdst=lds0+LDS_V+wid*1024, fdst=lds0+LDS_F;
  #define DMA_K(t,slot) glds16(ksrc+(long)(t)*KVBLK*DM,(unsigned)__builtin_amdgcn_readfirstlane(kdst+(slot)))
  #define DMA_V(t,slot) glds16(vsrc+(long)(t)*KVBLK*DM,(unsigned)__builtin_amdgcn_readfirstlane(vdst+(slot)))
  #define DMA_F(t,slot) glds4(fsrc+(long)(t)*KVBLK,(unsigned)__builtin_amdgcn_readfirstlane(fdst+((slot)>>5)))
  #define DMA_KM(slot) glds16(ksrcm,(unsigned)__builtin_amdgcn_readfirstlane(kdst+(slot)))
  #define DMA_VM(slot) glds16(vsrcm,(unsigned)__builtin_amdgcn_readfirstlane(vdst+(slot)))
  #define DMA_FM(slot) glds4(fsrcm,(unsigned)__builtin_amdgcn_readfirstlane(fdst+((slot)>>5)))
  const int vb0=(int)(lds0+LDS_V)+((lane>>4)&1)*32+(lane&3)*8+(4*hi+((lane&15)>>2))*64;
  const char*Kbase=shm+LDS_K; bf16x8 kf[8];
  const lds_cptr kp0=((lds_cptr)shm)+LDS_K+hi*1024+r32*16; const lds_cptr vp0=((lds_cptr)shm)+LDS_V+((lane>>4)&1)*32+(lane&3)*8+(4*hi+((lane&15)>>2))*64;
  const int NT=(q0+QB)/KVBLK+1;
  DMA_KM(0);DMA_FM(0);DMA_VM(0);DMA_K(1,SLOTB);DMA_F(1,SLOTB);
  bf16x8 qr[4];
  #pragma unroll
  for(int d0=0;d0<4;++d0)qr[d0]=*reinterpret_cast<const bf16x8*>(&Qw[(long)r32*DM+d0*16+hi*8]);
  float fqm=Fh[q0+wid*QBLK+r32];
  float l_reg=0.f;f32x16 o[2];o[0]=f32x16{};o[1]=f32x16{};
  const int qrel=wid*QBLK+r32;
  typedef __attribute__((address_space(3))) const f32x4_t* lds_f4ptr;
  #define CIN(P0,P1,fso) do{ const lds_f4ptr fp_=(lds_f4ptr)(shm3+LDS_F+(fso)+hi*16); \
    _Pragma("unroll") for(int g_=0;g_<4;++g_){ const f32x4_t a_=fp_[2*g_], b_=fp_[8+2*g_]; \
      P0[4*g_]=fqm-a_[0];P0[4*g_+1]=fqm-a_[1];P0[4*g_+2]=fqm-a_[2];P0[4*g_+3]=fqm-a_[3]; \
      P1[4*g_]=fqm-b_[0];P1[4*g_+1]=fqm-b_[1];P1[4*g_+2]=fqm-b_[2];P1[4*g_+3]=fqm-b_[3]; } }while(0)
  #define CMASK(P0,P1,t) do{int jb_=(t)-(NT-4); if(jb_>=0)cmask(P0,P1,jb_,qrel,hi);}while(0)
  bool resc=false;
  #define START(P0,P1) do{ const float rm=rowmax(P0,P1); resc=false; \
    if(__any(rm>(float)THRL)){ const float dl=__builtin_fmaxf(rm,0.f); fqm-=dl; \
      _Pragma("unroll") for(int r=0;r<16;++r){P0[r]=fsub_s(P0[r],dl);P1[r]=fsub_s(P1[r],dl);} } \
    _Pragma("unroll") for(int r=0;r<16;++r)P0[r]=__builtin_amdgcn_exp2f(P0[r]); }while(0)
  #define RESC() do{ if(resc){ asm volatile("s_waitcnt lgkmcnt(0)":::"memory"); \
      _Pragma("unroll") for(int d_=0;d_<2;++d_) _Pragma("unroll") for(int r=0;r<16;++r)o[d_][r]*=wsf[crow(r,hi)]; } }while(0)
  f32x16 pA0,pA1,pB0,pB1;
  int sl_prev=0,sl_cur=0,sl_next=SLOTB;
  #define ROT() do{sl_prev=sl_cur;sl_cur=sl_next;sl_next=(sl_next==(NSLOT-1)*SLOTB)?0:sl_next+SLOTB;}while(0)
  DMA_K(2,2*SLOTB);DMA_F(2,2*SLOTB);
  const lds_cptr shm3=(lds_cptr)shm;
  WAIT_BAR(6);
  CIN(pA0,pA1,0);
  qkt(pA0,pA1,Kbase,qr,r32,hi);asm volatile("s_nop 15\n\ts_nop 7":"+v"(pA0),"+v"(pA1));
  START(pA0,pA1);
  _Pragma("unroll") for(int r=0;r<16;++r)pA1[r]=__builtin_amdgcn_exp2f(pA1[r]);
  WAIT_BAR(0);
  DMA_K(3,0);DMA_F(3,0);DMA_V(1,SLOTB);
  ROT();
  kload8(kf,kp0+sl_cur);
  CIN(pB0,pB1,(sl_cur>>5));
  WAIT_BAR(3);
  s16x4 vlo[8],vhi[8]; u32x4 pw0,pw1,pw2,pw3;
  #define PKW(P,B) cvtpk_s(P[B],P[B+1])
  #define PAF(k) __builtin_bit_cast(bf16x8,pw##k)
  #define VFR(i) (bf16x8){vlo[i][0],vlo[i][1],vlo[i][2],vlo[i][3],vhi[i][0],vhi[i][1],vhi[i][2],vhi[i][3]}
  #define PIN(x) asm volatile("":"+v"(x))
  #define MX3(a,b,c) __builtin_fmaxf(__builtin_fmaxf((a),(b)),(c))
  #define GAPA(MF,A0,A1,A2,A3,W0,W1,PW) do{ MF; sacc+=A0; sacc+=A1; sacc+=A2; sacc+=A3; PIN(sacc); W0; W1; PIN(PW); SBAR(); }while(0)
  #define EX(v) __builtin_amdgcn_exp2f(v)
  #define GAPB(MF,X,B) do{ MF; X[B]=EX(X[B]); X[B+1]=EX(X[B+1]); X[B+2]=EX(X[B+2]); X[B+3]=EX(X[B+3]); PIN(X); SBAR(); }while(0)
  #define VRD(i) do{ vlo[i]=vtr(vp_+(((i)>>2)*4096+((i)&3)*1024)); vhi[i]=vtr(vp_+(((i)>>2)*4096+((i)&3)*1024+512)); }while(0)
  #define KRD(G,j) do{ if(G){ kload2(kf,kp0+sl_next,j); SBAR(); } }while(0)
  #define STEP(C0,C1,P0,P1,t,GK,GV,GL) do{ SBAR(); \
    const lds_cptr vp_=vp0+sl_prev; \
    VRD(0); SBAR(); float sacc=(P0[0]+P0[1]); \
    GAPA(C0=__builtin_amdgcn_mfma_f32_32x32x16_bf16(kf[0],qr[0],C0,0,0,0), P0[2],P0[3],P0[4],P0[5],     pw0[0]=PKW(P0,0), pw0[1]=PKW(P0,2), pw0); \
    VRD(4); SBAR(); GAPA(C1=__builtin_amdgcn_mfma_f32_32x32x16_bf16(kf[1],qr[0],C1,0,0,0), P0[6],P0[7],P0[8],P0[9],     pw0[2]=PKW(P0,4), pw0[3]=PKW(P0,6), pw0); \
    VRD(1); SBAR(); GAPA(C0=__builtin_amdgcn_mfma_f32_32x32x16_bf16(kf[2],qr[1],C0,0,0,0),   P0[10],P0[11],P0[12],P0[13], pw1[0]=PKW(P0,8), pw1[1]=PKW(P0,10), pw1); \
    VRD(5); SBAR(); GAPA(C1=__builtin_amdgcn_mfma_f32_32x32x16_bf16(kf[3],qr[1],C1,0,0,0),   P0[14],P0[15],P1[0],P1[1],   pw1[2]=PKW(P0,12),pw1[3]=PKW(P0,14), pw1); \
    VRD(2); SBAR(); GAPA(C0=__builtin_amdgcn_mfma_f32_32x32x16_bf16(kf[4],qr[2],C0,0,0,0),   P1[2],P1[3],P1[4],P1[5],     pw2[0]=PKW(P1,0), pw2[1]=PKW(P1,2), pw2); \
    VRD(6); SBAR(); GAPA(C1=__builtin_amdgcn_mfma_f32_32x32x16_bf16(kf[5],qr[2],C1,0,0,0),   P1[6],P1[7],P1[8],P1[9],     pw2[2]=PKW(P1,4), pw2[3]=PKW(P1,6), pw2); \
    VRD(3); SBAR(); GAPA(C0=__builtin_amdgcn_mfma_f32_32x32x16_bf16(kf[6],qr[3],C0,0,0,0),   P1[10],P1[11],P1[12],P1[13], pw3[0]=PKW(P1,8), pw3[1]=PKW(P1,10), pw3); \
    VRD(7); SBAR(); GAPA(C1=__builtin_amdgcn_mfma_f32_32x32x16_bf16(kf[7],qr[3],C1,0,0,0),   P1[14],P1[15],0.f,0.f,       pw3[2]=PKW(P1,12),pw3[3]=PKW(P1,14), pw3); \
    l_reg+=sacc; \
    if(GK){DMA_K((t)+3,sl_cur);DMA_F((t)+3,sl_cur);} if(GV){DMA_V((t)+1,sl_next);} \
    CMASK(C0,C1,t); \
    { float a=MX3(C0[0],C0[1],C1[0]),b=MX3(C0[2],C0[3],C1[1]); a=MX3(a,C1[2],C1[3]); \
      _Pragma("unroll") for(int r=4;r<16;r+=4){a=MX3(a,C0[r],C0[r+1]);b=MX3(b,C0[r+2],C0[r+3]);a=MX3(a,C1[r],C1[r+1]);b=MX3(b,C1[r+2],C1[r+3]);} \
      float rm=__builtin_fmaxf(a,b); { auto rr=__builtin_amdgcn_permlane32_swap(__float_as_uint(rm),__float_as_uint(rm),false,false); rm=__builtin_fmaxf(__uint_as_float(rr[0]),__uint_as_float(rr[1])); } \
      resc=false; \
      if(__builtin_expect(__any(rm>(float)THRL),0)){ const float dl=__builtin_fmaxf(rm,0.f); fqm-=dl; \
        _Pragma("unroll") for(int r=0;r<16;++r){C0[r]-=dl;C1[r]-=dl;} \
        const float f=__builtin_amdgcn_exp2f(-dl); l_reg*=f; if(hi==0)wsf[r32]=f; resc=true; } } \
    SBAR(); \
    GAPB(o[0]=__builtin_amdgcn_mfma_f32_32x32x16_bf16(PAF(0),VFR(0),o[0],0,0,0), C0,0); \
    GAPB(o[1]=__builtin_amdgcn_mfma_f32_32x32x16_bf16(PAF(0),VFR(4),o[1],0,0,0), C0,4); \
    KRD(GL,0); GAPB(o[0]=__builtin_amdgcn_mfma_f32_32x32x16_bf16(PAF(1),VFR(1),o[0],0,0,0), C0,8); \
    KRD(GL,1); GAPB(o[1]=__builtin_amdgcn_mfma_f32_32x32x16_bf16(PAF(1),VFR(5),o[1],0,0,0), C0,12); \
    KRD(GL,2); GAPB(o[0]=__builtin_amdgcn_mfma_f32_32x32x16_bf16(PAF(2),VFR(2),o[0],0,0,0), C1,0); \
    KRD(GL,3); GAPB(o[1]=__builtin_amdgcn_mfma_f32_32x32x16_bf16(PAF(2),VFR(6),o[1],0,0,0), C1,4); \
    GAPB(o[0]=__builtin_amdgcn_mfma_f32_32x32x16_bf16(PAF(3),VFR(3),o[0],0,0,0), C1,8); \
    GAPB(o[1]=__builtin_amdgcn_mfma_f32_32x32x16_bf16(PAF(3),VFR(7),o[1],0,0,0), C1,12); \
    if(GL){ CIN(P0,P1,(sl_next>>5)); } \
    }while(0)
  int t=1;
  #undef CMASK
  #define CMASK(P0,P1,t) do{}while(0)
  for(;t+5<NT;t+=2){
    STEP(pB0,pB1,pA0,pA1,t,true,true,true);     WAIT_BAR(3); RESC(); ROT();
    STEP(pA0,pA1,pB0,pB1,t+1,true,true,true);   WAIT_BAR(3); RESC(); ROT();
  }
  #undef CMASK
  #define CMASK(P0,P1,t) do{int jb_=(t)-(NT-4); if(jb_>=0)cmask(P0,P1,jb_,qrel,hi);}while(0)
  #define ENDW(tt) do{ if((tt)+3<NT){WAIT_BAR(3);} else if((tt)+2<NT){WAIT_BAR(1);} else {WAIT_BAR(0);} }while(0)
  for(;t+1<NT;t+=2){
    STEP(pB0,pB1,pA0,pA1,t,(t+3<NT),(t+1<NT),(t+1<NT));       ENDW(t);   RESC(); ROT();
    STEP(pA0,pA1,pB0,pB1,t+1,(t+4<NT),(t+2<NT),(t+2<NT));     ENDW(t+1); RESC(); ROT();
  }
  { float sacc=pA0[0]+pA0[1]; _Pragma("unroll") for(int r=2;r<16;++r)sacc+=pA0[r]; _Pragma("unroll") for(int r=0;r<16;++r)sacc+=pA1[r]; l_reg+=sacc;
    pw0=(u32x4){PKW(pA0,0),PKW(pA0,2),PKW(pA0,4),PKW(pA0,6)};pw1=(u32x4){PKW(pA0,8),PKW(pA0,10),PKW(pA0,12),PKW(pA0,14)};pw2=(u32x4){PKW(pA1,0),PKW(pA1,2),PKW(pA1,4),PKW(pA1,6)};pw3=(u32x4){PKW(pA1,8),PKW(pA1,10),PKW(pA1,12),PKW(pA1,14)};
    SBAR(); pv(o,vb0+sl_prev,PAF(0),PAF(1),PAF(2),PAF(3)); }
  #undef PKW
  #undef PAF
  #undef VFR
  #undef PIN
  #undef MX3
  #undef GAPA
  #undef GAPB
  #undef EX
  #undef VRD
  #undef KRD
  #undef STEP
  #undef ENDW
  {auto rr=__builtin_amdgcn_permlane32_swap(__float_as_uint(l_reg),__float_as_uint(l_reg),false,false);l_reg=__uint_as_float(rr[0])+__uint_as_float(rr[1]);}
  if(hi==0)wsf[32+r32]=l_reg;asm volatile("s_waitcnt lgkmcnt(0)":::"memory");
  float rli[16];
  #pragma unroll
  for(int r=0;r<16;++r)rli[r]=__builtin_amdgcn_rcpf(wsf[32+crow(r,hi)]);
  bf16*Ow=O+(rowbase+q0+wid*QBLK)*DM+h*D;
  { bf16*stg=(bf16*)(shm+LDS_OST)+wid*2048;
    #pragma unroll
    for(int r=0;r<16;++r){const int orow=crow(r,hi);
      #pragma unroll
      for(int d0=0;d0<2;++d0)stg[orow*64+d0*32+r32]=__float2bfloat16(o[d0][r]*rli[r]);}
    asm volatile("s_waitcnt lgkmcnt(0)":::"memory");
    #pragma unroll
    for(int i=0;i<4;++i){const int row=i*8+(lane>>3),ch=lane&7; const u32x4 v=*(const u32x4*)(stg+row*64+ch*8); ATTN_STORE16(Ow+(long)row*DM+ch*8,v);} }
  asm volatile("s_waitcnt lgkmcnt(0)\n\ts_barrier":::"memory");
  #undef DMA_K
  #undef DMA_V
  #undef DMA_F
  #undef DMA_KM
  #undef DMA_VM
  #undef DMA_FM
  #undef CIN
  #undef CMASK
  #undef START
  #undef RESC
  #undef ROT
}
constexpr int ATTN_LDS_BYTES=LDS_BYTES;
struct AttnTensors { const bf16* Q; const bf16* K; const bf16* V; const bf16* KM; const bf16* VM; const float* F2x; const float* F2m; bf16* O; };
struct AttnUnit { int bh; int qb; };
struct StaticOrder {
  int vcu;
  __device__ __forceinline__ explicit StaticOrder(int grid,int block):vcu((block%8)*(grid/8)+block/8){}
  __device__ __forceinline__ bool next(int i,AttnUnit&u)const{ if(i>=2)return false; const int s=vcu&15; u.bh=vcu>>4; u.qb=(i==0)?31-s:s; return true; }
  __device__ __forceinline__ void a_ready(const AttnUnit&)const{}
  __device__ __forceinline__ void done(const AttnUnit&)const{}
};
template<class Sched,int THRL=8> __device__ __forceinline__ void attn_phase(char*lds,const AttnTensors&T,const Sched&S){
  AttnUnit u;
  for(int i=0;S.next(i,u);++i){ S.a_ready(u); attn_unit<THRL>(u.bh/NHEAD,u.bh%NHEAD,u.qb,T.Q,T.K,T.V,T.KM,T.VM,T.F2x,T.F2m,T.O,lds); S.done(u); }
}
#undef SBAR
#undef WAIT_BAR
}
#define XB_TMO      128
#define XB_XCNT(j)  (256  + 64 * (j))
#define XB_XSUB(j)  (1280 + 64 * (j))
#define XB_XGEN(j)  (2304 + 64 * (j))
#define XB_TOP      3328
#define XB_TOPGEN   3392
#define XCD_BAR_WORDS 3456
#define XB_SPIN_CAP (1u << 18)
__device__ __forceinline__ unsigned xb_ld(unsigned* p)              { return __hip_atomic_load(p, __ATOMIC_RELAXED, __HIP_MEMORY_SCOPE_AGENT); }
__device__ __forceinline__ unsigned xb_add(unsigned* p, unsigned v) { return __hip_atomic_fetch_add(p, v, __ATOMIC_RELAXED, __HIP_MEMORY_SCOPE_AGENT); }
__device__ __forceinline__ unsigned xb_xcc_id() { return (unsigned)__builtin_amdgcn_s_getreg((3 << 11) | 20) & 0xFu; }
#define XB_SPIN(cond, bar) do { unsigned _sp = 0; while (cond) { __builtin_amdgcn_s_sleep(1); \
    if ((++_sp & 255u) == 0u) { if (xb_ld(&(bar)[XB_TMO])) break; if (_sp > XB_SPIN_CAP) { atomicAdd(&(bar)[XB_TMO], 1u); break; } } } } while (0)
struct XcdBarrier { unsigned* bar; unsigned x; volatile LAS unsigned* st; };
__device__ __forceinline__ XcdBarrier xcd_barrier_post(unsigned* bar, volatile LAS unsigned* st) {
    XcdBarrier b; b.bar = bar; b.x = xb_xcc_id(); b.st = st;
    if (threadIdx.x == 0) (void)xb_add(&bar[XB_XCNT(b.x)], 1u);
    return b;
}
__device__ __forceinline__ void xcd_barrier_complete(unsigned* bar, unsigned x, unsigned& nloc, unsigned& nx) {
    const unsigned G = gridDim.x * gridDim.y * gridDim.z;
    unsigned sum, cnt, mine, sp = 0u;
    for (;;) {
        sum = 0u; cnt = 0u; mine = 0u;
#pragma unroll
        for (unsigned j = 0; j < 16; ++j) { const unsigned c = xb_ld(&bar[XB_XCNT(j)]); sum += c; cnt += (c > 0u) ? 1u : 0u; mine = (j == x) ? c : mine; }
        if (sum == G) break;
        __builtin_amdgcn_s_sleep(1);
        if ((++sp & 255u) == 0u) { if (xb_ld(&bar[XB_TMO])) break; if (sp > XB_SPIN_CAP) { atomicAdd(&bar[XB_TMO], 1u); break; } }
    }
    nloc = mine > 0u ? mine : 1u; nx = cnt > 0u ? cnt : 1u;
}
__device__ __forceinline__ void xcd_barrier(const XcdBarrier& b) {
    asm volatile("s_waitcnt vmcnt(0)" ::: "memory");
    __syncthreads();
    if (threadIdx.x == 0) {
        unsigned* bar = b.bar;
        __builtin_amdgcn_s_waitcnt(0);
        unsigned nloc = b.st[0], nx = b.st[1];
        if (nloc == 0u) { xcd_barrier_complete(bar, b.x, nloc, nx); b.st[0] = nloc; b.st[1] = nx; }
        const unsigned old = xb_add(&bar[XB_XSUB(b.x)], 1u);
        const unsigned gen = old / nloc;
        if (old + 1u == (gen + 1u) * nloc) {
            __builtin_amdgcn_fence(__ATOMIC_RELEASE, "agent");
            asm volatile("s_waitcnt vmcnt(0)" ::: "memory");
            const unsigned og = xb_add(&bar[XB_TOP], 1u);
            const unsigned tg = og / nx;
            if (og + 1u == (tg + 1u) * nx) xb_add(&bar[XB_TOPGEN], 1u);
            else XB_SPIN(xb_ld(&bar[XB_TOPGEN]) == tg, bar);
            __builtin_amdgcn_fence(__ATOMIC_ACQUIRE, "agent");
            xb_add(&bar[XB_XGEN(b.x)], 1u);
            asm volatile("s_waitcnt vmcnt(0)" ::: "memory");
        } else {
            XB_SPIN(xb_ld(&bar[XB_XGEN(b.x)]) == gen, bar);
            __builtin_amdgcn_fence(__ATOMIC_ACQUIRE, "agent");
            asm volatile("s_waitcnt vmcnt(0)" ::: "memory");
        }
    }
    __syncthreads();
}

struct Frame {
    LAS unsigned char* lds; volatile LAS unsigned* MISC; unsigned* ctl; unsigned char* ws;
    int vcu, G;
    const float* in[31]; float* out;
};
enum InIdx { I_X = 0, I_META, I_LNG, I_LNB, I_WIN, I_BF, I_WUPA, I_WUPB, I_WO, I_ARE, I_AIM, I_LOGDT, I_BRE, I_BIM, I_CRE, I_CIM, I_SD, I_WGLU, I_BGLU, I_LN1G, I_LN1B,
             I_WR, I_BR, I_WG, I_BG, I_WU, I_BU, I_WD, I_BD, I_LN2G, I_LN2B };

struct TrRegs { f32x4 v[8]; };
__device__ __forceinline__ void tr_load(TrRegs& t, const float* W, int ldw, int k0, int n0s, int lane) {
    const float* p = W + (size_t)(k0 + (lane >> 3)) * ldw + n0s + 4 * (lane & 7);
#pragma unroll
    for (int i = 0; i < 8; ++i) t.v[i] = *(const f32x4*)(p + (size_t)(8 * i) * ldw);
}
__device__ __forceinline__ void tr_store(const TrRegs& t, int K, int k0, bf16* WT, int drow0, LAS float* scr, int lane) {
#pragma unroll
    for (int i = 0; i < 8; ++i) { LAS float* q = scr + (8 * i + (lane >> 3)) * 33 + 4 * (lane & 7); q[0] = t.v[i].x; q[1] = t.v[i].y; q[2] = t.v[i].z; q[3] = t.v[i].w; }
    LDS_WAIT(); asm volatile("" ::: "memory");
    const int c = lane & 7;
#pragma unroll
    for (int j = 0; j < 4; ++j) { const int n = (lane >> 3) + 8 * j; const LAS float* sp = scr + (8 * c) * 33 + n;
        u32x4 o; o.x = pk2(sp[0 * 33], sp[1 * 33]); o.y = pk2(sp[2 * 33], sp[3 * 33]); o.z = pk2(sp[4 * 33], sp[5 * 33]); o.w = pk2(sp[6 * 33], sp[7 * 33]);
        *(u32x4*)(WT + (size_t)(drow0 + n) * K + k0 + 8 * c) = o; }
    LDS_WAIT(); asm volatile("" ::: "memory");
}
__device__ __forceinline__ void p0_transpose_item(const float* W, int ldw, int K, int k0, int n0s, bf16* WT, int drow0, LAS float* scr, int lane) {
    TrRegs t; tr_load(t, W, ldw, k0, n0s, lane); tr_store(t, K, k0, WT, drow0, scr, lane);
}
__device__ __forceinline__ void ln_row_stats(const float* xrow, int lane, f32x4 (&v)[4]) {
    const f32x4* xr = (const f32x4*)xrow + lane; float s = 0.f;
#pragma unroll
    for (int j = 0; j < 4; ++j) { v[j] = xr[64 * j]; s += (v[j].x + v[j].y) + (v[j].z + v[j].w); }
    const float mean = wave_sum(s) * (1.f / D); float s2 = 0.f;
#pragma unroll
    for (int j = 0; j < 4; ++j) { v[j] = v[j] - mean; s2 += (v[j].x * v[j].x + v[j].y * v[j].y) + (v[j].z * v[j].z + v[j].w * v[j].w); }
    const float rstd = 1.f / sqrtf(wave_sum(s2) * (1.f / D) + LN_EPS);
#pragma unroll
    for (int j = 0; j < 4; ++j) v[j] = v[j] * rstd;
}

__device__ __forceinline__ void p0_prologue(Frame& F) {
    const int tid_ = fresh_tid(), lane = tid_ & 63, wave = __builtin_amdgcn_readfirstlane(tid_ >> 6);
    const float* lng = F.in[I_LNG]; const float* lnb = F.in[I_LNB]; const float* w_in = F.in[I_WIN];
    f32x4 gv[4], bv[4];
#pragma unroll
    for (int j = 0; j < 4; ++j) { gv[j] = *((const f32x4*)lng + lane + 64 * j); bv[j] = *((const f32x4*)lnb + lane + 64 * j); }
    if (blockIdx.x < 25) {
        LAS float* hm = (LAS float*)F.lds;
        LAS float* red = (LAS float*)(F.lds + 65536);
#pragma unroll
        for (int rr = 0; rr < 2; ++rr) { const int r = 2 * wave + rr; f32x4 v[4]; ln_row_stats(F.in[I_META] + (size_t)r * D, lane, v);
#pragma unroll
            for (int j = 0; j < 4; ++j) { const f32x4 h = v[j] * gv[j] + bv[j]; const int k = 256 * j + 4 * lane;
                hm[(k + 0) * 16 + r] = h.x; hm[(k + 1) * 16 + r] = h.y; hm[(k + 2) * 16 + r] = h.z; hm[(k + 3) * 16 + r] = h.w; } }
        __syncthreads();
        const int col = 512 + 64 * (int)blockIdx.x + lane; const bool valid = col < GA_OFF;
        float acc[16];
#pragma unroll
        for (int r = 0; r < 16; ++r) acc[r] = 0.f;
        for (int k0 = 128 * wave; k0 < 128 * wave + 128; k0 += 16) { float wv[16];
#pragma unroll
            for (int kk = 0; kk < 16; ++kk) wv[kk] = valid ? w_in[(size_t)(k0 + kk) * IN_COLS + col] : 0.f;
#pragma unroll
            for (int kk = 0; kk < 16; ++kk) { const LAS f32x4* hp = (const LAS f32x4*)(hm + (k0 + kk) * 16);
#pragma unroll
                for (int q = 0; q < 4; ++q) { const f32x4 h = hp[q]; acc[4 * q + 0] += h.x * wv[kk]; acc[4 * q + 1] += h.y * wv[kk]; acc[4 * q + 2] += h.z * wv[kk]; acc[4 * q + 3] += h.w * wv[kk]; } } }
#pragma unroll
        for (int r = 0; r < 16; ++r) red[(wave * 16 + r) * 64 + lane] = acc[r];
        __syncthreads();
        unsigned char* sm = F.ws + WS_SMALL;
#pragma unroll
        for (int rr = 0; rr < 2; ++rr) { const int r = 2 * wave + rr; float s = 0.f;
#pragma unroll
            for (int w = 0; w < 8; ++w) s += red[(w * 16 + r) * 64 + lane];
            if (valid) {
                if (col < 1024) ((bf16*)(sm + SM_KMETA))[r * AW + col - 512] = (bf16)f2bf(s);
                else if (col < F_OFF) ((bf16*)(sm + SM_VMETA))[r * AW + col - 1024] = (bf16)f2bf(s);
                else if (col < U_OFF) ((float*)(sm + SM_LOGFM))[r * 8 + col - F_OFF] = log_sigmoidf_(s + F.in[I_BF][col - F_OFF]);
                else ((float*)(sm + SM_UMETA))[r * SW + col - U_OFF] = s;
            } }
        __syncthreads();
    }
    if (blockIdx.x == 58) {
        float* wrt = (float*)(F.ws + WS_SMALL + SM_WRT); const float* wr = F.in[I_WR];
        for (int i = tid_; i < D * NE; i += NWAVES * 64) { const int e = i >> 10, k = i & 1023; wrt[i] = wr[(size_t)k * NE + e]; }
    }
    if (blockIdx.x == 25) {
        u32x4* kz = (u32x4*)(F.ws + WS_SMALL + SM_KMETA + 16 * AW * 2); u32x4* vz = (u32x4*)(F.ws + WS_SMALL + SM_VMETA + 16 * AW * 2);
        for (int i = tid_; i < 48 * AW * 2 / 16; i += NWAVES * 64) { kz[i] = (u32x4){0u, 0u, 0u, 0u}; vz[i] = (u32x4){0u, 0u, 0u, 0u}; }
    }
    if (blockIdx.x >= 26 && blockIdx.x < 26 + NG) {
        const int g = (int)blockIdx.x - 26;
        LAS float* Apr = (LAS float*)F.lds; LAS float* Api = Apr + 17 * 64;
        LAS float* Bbr = Api + 17 * 64; LAS float* Bbi = Bbr + 1024;
        LAS float* Cr = Bbi + 1024; LAS float* Ci = Cr + 1024;
        LAS float* Kt = Ci + 1024;
        if (tid_ < 64) { const int p = tid_;
            const float dt = __expf(F.in[I_LOGDT][g]); const float are = F.in[I_ARE][g * NP + p], aim = F.in[I_AIM][g * NP + p];
            const float mag = __expf(are * dt); float sn, cs; sincos_acc(aim * dt, sn, cs);
            const float lbr = mag * cs, lbi = mag * sn, den = are * are + aim * aim, zr = lbr - 1.0f, zi = lbi;
            const float cfr = (zr * are + zi * aim) / den, cfi = (zi * are - zr * aim) / den;
            for (int c = 0; c < 16; ++c) { const float br = F.in[I_BRE][((size_t)g * NP + p) * GC + c], bi = F.in[I_BIM][((size_t)g * NP + p) * GC + c];
                Bbr[p * 16 + c] = cfr * br - cfi * bi; Bbi[p * 16 + c] = cfr * bi + cfi * br; }
            float pr = 1.0f, pi = 0.0f;
            for (int n = 0; n <= 16; ++n) { Apr[n * 64 + p] = pr; Api[n * 64 + p] = pi; const float nr = pr * lbr - pi * lbi, ni = pr * lbi + pi * lbr; pr = nr; pi = ni; } }
        for (int i = tid_; i < 1024; i += NWAVES * 64) { Cr[i] = F.in[I_CRE][(size_t)g * 1024 + i]; Ci[i] = F.in[I_CIM][(size_t)g * 1024 + i]; }
        __syncthreads();
        for (int idx = tid_; idx < 4096; idx += NWAVES * 64) { const int tau = idx >> 8, cp = (idx >> 4) & 15, c = idx & 15; float sacc = 0.f;
            for (int p = 0; p < 64; ++p) { const float ar = Apr[tau * 64 + p], ai = Api[tau * 64 + p], br = Bbr[p * 16 + c], bi = Bbi[p * 16 + c];
                const float er = ar * br - ai * bi, ei = ar * bi + ai * br; sacc += Cr[cp * 64 + p] * er - Ci[cp * 64 + p] * ei; }
            Kt[idx] = sacc + ((tau == 0 && cp == c) ? F.in[I_SD][g * GC + cp] : 0.f); }
        __syncthreads();
        bf16* WY = (bf16*)(F.ws + WS_WY) + (size_t)g * 256 * 384; bf16* WSg = (bf16*)(F.ws + WS_WSS) + (size_t)g * 256 * 256;
        for (int q = tid_; q < 256 * 48; q += NWAVES * 64) { const int n = q / 48, k0 = (q - n * 48) * 8, jp = n >> 4, cp = n & 15; float v[8];
            if (k0 < 256) { const int j = k0 >> 4, c0 = k0 & 15;
#pragma unroll
                for (int i = 0; i < 8; ++i) v[i] = (j <= jp) ? Kt[((jp - j) * 16 + cp) * 16 + c0 + i] : 0.f; }
            else { const int ks = k0 - 256, p0 = ks & 63; const bool im = ks >= 64;
#pragma unroll
                for (int i = 0; i < 8; ++i) { const int p = p0 + i; const float ar = Apr[(jp + 1) * 64 + p], ai = Api[(jp + 1) * 64 + p], cr = Cr[cp * 64 + p], ci = Ci[cp * 64 + p];
                    v[i] = im ? -(cr * ai + ci * ar) : (cr * ar - ci * ai); } }
            u32x4 o; o.x = pk2(v[0], v[1]); o.y = pk2(v[2], v[3]); o.z = pk2(v[4], v[5]); o.w = pk2(v[6], v[7]); *(u32x4*)(WY + (size_t)n * 384 + k0) = o; }
        for (int q = tid_; q < 256 * 32; q += NWAVES * 64) { const int n = q >> 5, k0 = (q & 31) * 8, j = k0 >> 4, c0 = k0 & 15; float v[8];
            if (n < 128) { const int p = n & 63; const bool im = n >= 64; const float ar = Apr[(15 - j) * 64 + p], ai = Api[(15 - j) * 64 + p];
#pragma unroll
                for (int i = 0; i < 8; ++i) { const float br = Bbr[p * 16 + c0 + i], bi = Bbi[p * 16 + c0 + i]; v[i] = im ? (ar * bi + ai * br) : (ar * br - ai * bi); } }
            else {
#pragma unroll
                for (int i = 0; i < 8; ++i) v[i] = 0.f; }
            u32x4 o; o.x = pk2(v[0], v[1]); o.y = pk2(v[2], v[3]); o.z = pk2(v[4], v[5]); o.w = pk2(v[6], v[7]); *(u32x4*)(WSg + (size_t)n * 256 + k0) = o; }
        __syncthreads();
    }
    {
        LAS float* scr = (LAS float*)(F.lds + wave * 16384);
        const int gw = ((int)blockIdx.x - 59) * NWAVES + wave, NGW = (F.G - 59) * NWAVES;
        if (blockIdx.x >= 59) {
        constexpr int I_IN = 16 * 128, I_UA = 8 * 32, I_UB = 8 * 32, I_O = 16 * 32, I_GL = 8 * 16, I_GU = 16 * 64, I_DN = 16 * 32;
        constexpr int NDENSE = I_IN + I_UA + I_UB + I_O + I_GL;
        for (int it = gw; it < NDENSE; it += NGW) {
            int r = it;
            if (r < I_IN) { const int kb = r / 128, nb = r % 128, n0 = 32 * nb; p0_transpose_item(w_in, IN_COLS, D, 64 * kb, n0 + (n0 >= F_OFF ? 8 : 0), (bf16*)(F.ws + WS_WIN), n0, scr, lane); continue; } r -= I_IN;
            if (r < I_UA) { const int kb = r / 32, nb = r % 32; p0_transpose_item(F.in[I_WUPA], D, AW, 64 * kb, 32 * nb, (bf16*)(F.ws + WS_WUPA), 32 * nb, scr, lane); continue; } r -= I_UA;
            if (r < I_UB) { const int kb = r / 32, nb = r % 32; p0_transpose_item(F.in[I_WUPB], D, SW, 64 * kb, 32 * nb, (bf16*)(F.ws + WS_WUPB), 32 * nb, scr, lane); continue; } r -= I_UB;
            if (r < I_O) { const int kb = r / 32, nb = r % 32; p0_transpose_item(F.in[I_WO], D, D, 64 * kb, 32 * nb, (bf16*)(F.ws + WS_WO), 32 * nb, scr, lane); continue; } r -= I_O;
            { const int kb = r / 16, nb = r % 16; p0_transpose_item(F.in[I_WGLU], SW, SW, 64 * kb, 32 * nb, (bf16*)(F.ws + WS_WGLU), 32 * nb, scr, lane); }
        }
        float wf[16][8];
#pragma unroll
        for (int j = 0; j < 4; ++j)
#pragma unroll
            for (int i = 0; i < 4; ++i) { const float* p = w_in + (size_t)(256 * j + 4 * lane + i) * IN_COLS + F_OFF; const f32x4 a = *(const f32x4*)p, b = *(const f32x4*)(p + 4);
                wf[4 * j + i][0] = a.x; wf[4 * j + i][1] = a.y; wf[4 * j + i][2] = a.z; wf[4 * j + i][3] = a.w; wf[4 * j + i][4] = b.x; wf[4 * j + i][5] = b.y; wf[4 * j + i][6] = b.z; wf[4 * j + i][7] = b.w; }
        const float bfl = F.in[I_BF][lane & 7];
        bf16* XN = (bf16*)(F.ws + WS_XN); float* logf = (float*)(F.ws + WS_LOGF);
        for (int m0 = gw; m0 < M; m0 += 2 * NGW) {
            f32x4 v[2][4]; const bool has2 = (m0 + NGW) < M;
            { const f32x4* xa = (const f32x4*)(F.in[I_X] + (size_t)m0 * D) + lane; const f32x4* xb = (const f32x4*)(F.in[I_X] + (size_t)(has2 ? m0 + NGW : m0) * D) + lane; float s = 0.f, t = 0.f;
#pragma unroll
              for (int j = 0; j < 4; ++j) { v[0][j] = xa[64 * j]; v[1][j] = xb[64 * j]; }
#pragma unroll
              for (int j = 0; j < 4; ++j) { s += (v[0][j].x + v[0][j].y) + (v[0][j].z + v[0][j].w); t += (v[1][j].x + v[1][j].y) + (v[1][j].z + v[1][j].w); }
              const float ma = wave_sum(s) * (1.f / D), mb = wave_sum(t) * (1.f / D); float s2 = 0.f, t2 = 0.f;
#pragma unroll
              for (int j = 0; j < 4; ++j) { v[0][j] = v[0][j] - ma; v[1][j] = v[1][j] - mb; s2 += (v[0][j].x * v[0][j].x + v[0][j].y * v[0][j].y) + (v[0][j].z * v[0][j].z + v[0][j].w * v[0][j].w);
                  t2 += (v[1][j].x * v[1][j].x + v[1][j].y * v[1][j].y) + (v[1][j].z * v[1][j].z + v[1][j].w * v[1][j].w); }
              const float ra = 1.f / sqrtf(wave_sum(s2) * (1.f / D) + LN_EPS), rb = 1.f / sqrtf(wave_sum(t2) * (1.f / D) + LN_EPS);
#pragma unroll
              for (int j = 0; j < 4; ++j) { v[0][j] = v[0][j] * ra; v[1][j] = v[1][j] * rb; } }
#pragma unroll
            for (int r = 0; r < 2; ++r) { const int m = m0 + r * NGW; if (r == 1 && !has2) break;
                float fs[8];
#pragma unroll
                for (int h = 0; h < 8; ++h) fs[h] = 0.f;
                unsigned long long* o8 = (unsigned long long*)(XN + (size_t)m * D) + lane;
#pragma unroll
                for (int j = 0; j < 4; ++j) { const f32x4 h = v[r][j] * gv[j] + bv[j];
                    o8[64 * j] = (unsigned long long)pk2(h.x, h.y) | ((unsigned long long)pk2(h.z, h.w) << 32);
#pragma unroll
                    for (int hh = 0; hh < 8; ++hh) fs[hh] += h.x * wf[4 * j + 0][hh] + h.y * wf[4 * j + 1][hh] + h.z * wf[4 * j + 2][hh] + h.w * wf[4 * j + 3][hh]; }
#pragma unroll
                for (int hh = 0; hh < 8; ++hh) fs[hh] = wave_sum(fs[hh]);
                const int l7 = lane & 7;
                const float mine = (l7 == 0) ? fs[0] : (l7 == 1) ? fs[1] : (l7 == 2) ? fs[2] : (l7 == 3) ? fs[3] : (l7 == 4) ? fs[4] : (l7 == 5) ? fs[5] : (l7 == 6) ? fs[6] : fs[7];
                if (lane < 8) logf[(size_t)m * 8 + lane] = log_sigmoidf_(mine + bfl); }
        }
        }
    }
}

__device__ __forceinline__ void p1_fcumsum(Frame& F) {
    if (blockIdx.x >= 16) return;
    const int tid_ = fresh_tid(), lane = tid_ & 63, wave = __builtin_amdgcn_readfirstlane(tid_ >> 6);
    const int b = blockIdx.x >> 3, h = blockIdx.x & 7;
    LAS float* wtot = (LAS float*)(F.lds + LDSCTL_OFF + 4096);
    const float* logfm = (const float*)(F.ws + WS_SMALL + SM_LOGFM); float* F2m = (float*)(F.ws + WS_SMALL + SM_F2M);
    float mt = 0.f;
    for (int j = 0; j < NMETA; ++j) { mt += logfm[j * 8 + h]; if (b == 0 && wave == 0 && lane == 0) F2m[h * 64 + j] = mt * LOG2E; }
    if (b == 0 && wave == 0 && lane >= NMETA) F2m[h * 64 + lane] = INFINITY;
    const int t0 = 1024 * wave + 16 * lane;
    const float* lf = (const float*)(F.ws + WS_LOGF) + ((size_t)b * SEQ + t0) * 8 + h; float* F2x = (float*)(F.ws + WS_F2X) + (size_t)(b * 8 + h) * SEQ + t0;
    float v[16]; float s = 0.f;
#pragma unroll
    for (int i = 0; i < 16; ++i) { v[i] = lf[(size_t)i * 8]; s += v[i]; }
    float inc = s;
#pragma unroll
    for (int o = 1; o < 64; o <<= 1) { const float t = __shfl_up(inc, o); if (lane >= o) inc += t; }
    if (lane == 63) wtot[wave] = inc;
    __syncthreads();
    float run = mt + (inc - s);
    for (int w = 0; w < wave; ++w) run += wtot[w];
    f32x4 o4[4];
#pragma unroll
    for (int i = 0; i < 16; ++i) { run += v[i]; o4[i >> 2][i & 3] = run * LOG2E; }
#pragma unroll
    for (int q = 0; q < 4; ++q) *(f32x4*)(F2x + 4 * q) = o4[q];
    __syncthreads();
}
__device__ __forceinline__ void ssm_chunk_scan(Frame& F, int b, int g) {
    const int tid_ = fresh_tid(), lane = tid_ & 63, wave = __builtin_amdgcn_readfirstlane(tid_ >> 6), p = lane;
    LAS f32x2* Tt = (LAS f32x2*)F.lds;
    const float dt = __expf(F.in[I_LOGDT][g]); const float are = F.in[I_ARE][g * NP + p], aim = F.in[I_AIM][g * NP + p];
    const float mag = __expf(are * dt); float sn, cs; sincos_acc(aim * dt, sn, cs);
    const float lbr = mag * cs, lbi = mag * sn, den = are * are + aim * aim, zr = lbr - 1.0f, zi = lbi;
    const float cfr = (zr * are + zi * aim) / den, cfi = (zi * are - zr * aim) / den;
    float ar = lbr, ai = lbi;
#pragma unroll
    for (int q = 0; q < 4; ++q) { const float nr = ar * ar - ai * ai, ni = 2.0f * ar * ai; ar = nr; ai = ni; }
    const float* SS = (const float*)(F.ws + WS_SS) + ((size_t)g * 1024 + (size_t)b * 512 + 64 * wave) * 128;
    float xr = 0.f, xi = 0.f;
#pragma unroll 1
    for (int c0 = 0; c0 < 64; c0 += 16) { float sr[16], si[16];
#pragma unroll
        for (int i = 0; i < 16; ++i) { sr[i] = SS[(size_t)(c0 + i) * 128 + p]; si[i] = SS[(size_t)(c0 + i) * 128 + 64 + p]; }
#pragma unroll
        for (int i = 0; i < 16; ++i) { const float nr = ar * xr - ai * xi + sr[i], ni = ar * xi + ai * xr + si[i]; xr = nr; xi = ni; } }
    Tt[wave * 64 + lane] = (f32x2){xr, xi};
    float mr = 0.f, mi = 0.f;
    { float bbr[16], bbi[16];
#pragma unroll
      for (int c = 0; c < 16; ++c) { const float br = F.in[I_BRE][((size_t)g * NP + p) * GC + c], bi = F.in[I_BIM][((size_t)g * NP + p) * GC + c]; bbr[c] = cfr * br - cfi * bi; bbi[c] = cfr * bi + cfi * br; }
      const float* Um = (const float*)(F.ws + WS_SMALL + SM_UMETA) + g * GC;
      float um[16];
#pragma unroll
      for (int j = 0; j < NMETA; ++j) um[j] = Um[(size_t)j * SW + (lane & 15)];
#pragma unroll
      for (int j = 0; j < NMETA; ++j) { float bur = 0.f, bui = 0.f;
#pragma unroll
          for (int c = 0; c < 16; ++c) { const float u = __builtin_bit_cast(float, __builtin_amdgcn_readlane(__builtin_bit_cast(int, um[j]), c)); bur += bbr[c] * u; bui += bbi[c] * u; }
          const float nr = lbr * mr - lbi * mi + bur, ni = lbr * mi + lbi * mr + bui; mr = nr; mi = ni; } }
    __syncthreads();
    float a64r = ar, a64i = ai;
#pragma unroll
    for (int q = 0; q < 6; ++q) { const float nr = a64r * a64r - a64i * a64i, ni = 2.0f * a64r * a64i; a64r = nr; a64i = ni; }
    float cr = mr, ci = mi;
    for (int w = 0; w < wave; ++w) { const f32x2 t = Tt[w * 64 + lane]; const float nr = a64r * cr - a64i * ci + t.x, ni = a64r * ci + a64i * cr + t.y; cr = nr; ci = ni; }
    bf16* XP = (bf16*)(F.ws + WS_U3) + ((size_t)g * 1024 + (size_t)b * 512 + 64 * wave) * 384 + 256;
    xr = cr; xi = ci;
#pragma unroll 1
    for (int c0 = 0; c0 < 64; c0 += 16) { float sr[16], si[16];
#pragma unroll
        for (int i = 0; i < 16; ++i) { sr[i] = SS[(size_t)(c0 + i) * 128 + p]; si[i] = SS[(size_t)(c0 + i) * 128 + 64 + p]; }
#pragma unroll
        for (int i = 0; i < 16; ++i) { XP[(size_t)(c0 + i) * 384 + p] = (bf16)f2bf(xr); XP[(size_t)(c0 + i) * 384 + 64 + p] = (bf16)f2bf(xi);
            const float nr = ar * xr - ai * xi + sr[i], ni = ar * xi + ai * xr + si[i]; xr = nr; xi = ni; } }
}
__device__ __forceinline__ void ssm_job(Frame& F0, int b, int g) {
    using namespace pg8;
    Frame F = F0; { unsigned char* w_ = F.ws; asm volatile("" : "+s"(w_)); F.ws = w_; }
    { SsmSched S; S.A = (const char*)(F.ws + WS_U3) + (size_t)g * 1024 * 384 * 2; S.Bt = (const char*)(F.ws + WS_WSS) + (size_t)g * 256 * 256 * 2; S.a_tstep = (size_t)BM * 384 * 2; S.pm0 = 2 * b; S.g = g;
      EpiS E{(float*)(F.ws + WS_SS)};
      int K1 = 256; asm volatile("" : "+s"(K1));
      gemm_phase<EpiS, SsmSched, true, false>(F.lds, K1, 384, 256, S, E); }
    __syncthreads();
    ssm_chunk_scan(F, b, g);
    VM_WAIT(); __syncthreads();
    { SsmSched S; S.A = (const char*)(F.ws + WS_U3) + (size_t)g * 1024 * 384 * 2; S.Bt = (const char*)(F.ws + WS_WY) + (size_t)g * 256 * 384 * 2; S.a_tstep = (size_t)BM * 384 * 2; S.pm0 = 2 * b; S.g = g;
      EpiY E{(bf16*)(F.ws + WS_YB)};
      int K3 = 384; asm volatile("" : "+s"(K3));
      gemm_phase<EpiY, SsmSched, true, false>(F.lds, K3, 384, 384, S, E); }
}
struct TrItem { const float* src; bf16* dst; int k0, n0s, drow0; };
__device__ __forceinline__ TrItem moe_item(Frame& F, int e, int r) {
    constexpr int I_GU = 16 * 64; TrItem it;
    if (r < I_GU) { const int kb = r / 64, nb = r % 64, dr = 32 * nb, pn = dr >> 8, jj = dr & 255;
        it.src = (jj < 128 ? F.in[I_WG] : F.in[I_WU]) + (size_t)e * D * D; it.n0s = pn * 128 + (jj & 127); it.k0 = 64 * kb; it.dst = (bf16*)(F.ws + WS_WGU) + (size_t)e * 2048 * D; it.drow0 = dr; }
    else { r -= I_GU; const int kb = r / 32, nb = r % 32; it.src = F.in[I_WD] + (size_t)e * D * D; it.n0s = 32 * nb; it.k0 = 64 * kb; it.dst = (bf16*)(F.ws + WS_WD) + (size_t)e * D * D; it.drow0 = 32 * nb; }
    return it;
}
__device__ __forceinline__ void moe_convert_job(Frame& F0, int cj) {
    Frame F = F0; { unsigned char* w_ = F.ws; asm volatile("" : "+s"(w_)); F.ws = w_; }
    const int tid_ = fresh_tid(), lane = tid_ & 63, wave = __builtin_amdgcn_readfirstlane(tid_ >> 6);
    LAS float* scr = (LAS float*)(F.lds + wave * 16384);
    const int e = cj / 12, sl = cj - e * 12;
#pragma unroll 1
    for (int q = 0; q < 16; q += 4) { const int r = sl * 128 + wave * 16 + q;
        const TrItem i0 = moe_item(F, e, r), i1 = moe_item(F, e, r + 1), i2 = moe_item(F, e, r + 2), i3 = moe_item(F, e, r + 3);
        TrRegs t0, t1, t2, t3;
        tr_load(t0, i0.src, D, i0.k0, i0.n0s, lane); tr_load(t1, i1.src, D, i1.k0, i1.n0s, lane); tr_load(t2, i2.src, D, i2.k0, i2.n0s, lane); tr_load(t3, i3.src, D, i3.k0, i3.n0s, lane);
        tr_store(t0, D, i0.k0, i0.dst, i0.drow0, scr, lane); tr_store(t1, D, i1.k0, i1.dst, i1.drow0, scr, lane); tr_store(t2, D, i2.k0, i2.dst, i2.drow0, scr, lane); tr_store(t3, D, i3.k0, i3.dst, i3.drow0, scr, lane); }
}
__device__ __forceinline__ int fetch_job(Frame& F, int qsel) {
    volatile LAS int* slot = (volatile LAS int*)(F.MISC + 16);
    if (threadIdx.x == 0) *slot = (int)__hip_atomic_fetch_add(F.ctl + CW_QHEAD + 64 * qsel, 1u, RLX_AGENT);
    __syncthreads(); const int j = *slot; __syncthreads(); return j;
}

__device__ __forceinline__ void p6_ln1_router(Frame& F, int dummy) {
    const int tid_ = fresh_tid(), lane = tid_ & 63, wave = __builtin_amdgcn_readfirstlane(tid_ >> 6);
    const int gw = F.vcu * NWAVES + wave, NGW = F.G * NWAVES;
    const f32x4* gp = (const f32x4*)F.in[I_LN1G] + lane; const f32x4* bp = (const f32x4*)F.in[I_LN1B] + lane;
    const float* MIX = (const float*)(F.ws + WS_MIX); bf16* H1B = (bf16*)(F.ws + WS_H1B);
    LAS float* Wt = (LAS float*)F.lds;
    LAS unsigned* lcnt = (LAS unsigned*)(F.lds + LDSCTL_OFF + 2048); LAS unsigned* lbase = lcnt + 32; LAS unsigned* ent = lcnt + 64;
    { const f32x4* wrt = (const f32x4*)(F.ws + WS_SMALL + SM_WRT); for (int i = tid_; i < D * NE / 4; i += NWAVES * 64) ((LAS f32x4*)Wt)[i] = wrt[i]; }
    if (tid_ < 32) lcnt[tid_] = 0u;
    __syncthreads();
    const int emine = (lane >> 1) & 31; const float brm = F.in[I_BR][emine];
    const bool b5 = lane & 32, b4 = lane & 16, b3 = lane & 8, b2 = lane & 4, b1 = lane & 2;
    int* list = (int*)(F.ws + (dummy ? WS_Q : WS_LIST)); float* wslot = (float*)(F.ws + (dummy ? WS_K : WS_WSLOT)); unsigned* cnt = F.ctl + CW_CNT + (dummy ? 64 : 0);
#pragma unroll 1
    for (int pr = 0; pr < 4; ++pr) {
        const int m0 = gw + (2 * pr) * NGW, m1 = m0 + NGW;
        const f32x4* xr0 = (const f32x4*)(MIX + (size_t)m0 * D) + lane; const f32x4* xr1 = (const f32x4*)(MIX + (size_t)m1 * D) + lane;
        float mean0, rstd0, mean1, rstd1;
        { f32x4 v[4], w[4]; float s = 0.f, t = 0.f;
#pragma unroll
          for (int j = 0; j < 4; ++j) { v[j] = xr0[64 * j]; w[j] = xr1[64 * j]; s += (v[j].x + v[j].y) + (v[j].z + v[j].w); t += (w[j].x + w[j].y) + (w[j].z + w[j].w); }
          mean0 = wave_sum(s) * (1.f / D); mean1 = wave_sum(t) * (1.f / D); float s2 = 0.f, t2 = 0.f;
#pragma unroll
          for (int j = 0; j < 4; ++j) { const f32x4 d = v[j] - mean0, e = w[j] - mean1; s2 += (d.x * d.x + d.y * d.y) + (d.z * d.z + d.w * d.w); t2 += (e.x * e.x + e.y * e.y) + (e.z * e.z + e.w * e.w); }
          rstd0 = 1.f / sqrtf(wave_sum(s2) * (1.f / D) + LN_EPS); rstd1 = 1.f / sqrtf(wave_sum(t2) * (1.f / D) + LN_EPS); }
        float pa[32], pb[32];
#pragma unroll
        for (int e = 0; e < 32; ++e) { pa[e] = 0.f; pb[e] = 0.f; }
        unsigned long long* o0 = (unsigned long long*)(H1B + (size_t)m0 * D) + lane; unsigned long long* o1 = (unsigned long long*)(H1B + (size_t)m1 * D) + lane;
#pragma unroll 1
        for (int j = 0; j < 4; ++j) { const f32x4 g = gp[64 * j], bb = bp[64 * j];
            const f32x4 h0 = (xr0[64 * j] - mean0) * rstd0 * g + bb, h1 = (xr1[64 * j] - mean1) * rstd1 * g + bb;
            o0[64 * j] = (unsigned long long)pk2(h0.x, h0.y) | ((unsigned long long)pk2(h0.z, h0.w) << 32);
            o1[64 * j] = (unsigned long long)pk2(h1.x, h1.y) | ((unsigned long long)pk2(h1.z, h1.w) << 32);
            const LAS f32x4* wp = (const LAS f32x4*)(Wt + 256 * j + 4 * lane);
#pragma unroll
            for (int e = 0; e < 32; ++e) { const f32x4 w = wp[e * 256];
                pa[e] += (h0.x * w.x + h0.y * w.y) + (h0.z * w.z + h0.w * w.w); pb[e] += (h1.x * w.x + h1.y * w.y) + (h1.z * w.z + h1.w * w.w); } }
        float val0, val1;
#define P6_REDUCE(part, out) do { float r16[16], r8[8], r4[4], r2[2], r1; \
        _Pragma("unroll") for (int i = 0; i < 16; ++i) { const float keep = b5 ? part[i + 16] : part[i], send = b5 ? part[i] : part[i + 16]; r16[i] = keep + __shfl_xor(send, 32); } \
        _Pragma("unroll") for (int i = 0; i < 8; ++i) { const float keep = b4 ? r16[i + 8] : r16[i], send = b4 ? r16[i] : r16[i + 8]; r8[i] = keep + __shfl_xor(send, 16); } \
        _Pragma("unroll") for (int i = 0; i < 4; ++i) { const float keep = b3 ? r8[i + 4] : r8[i], send = b3 ? r8[i] : r8[i + 4]; r4[i] = keep + __shfl_xor(send, 8); } \
        _Pragma("unroll") for (int i = 0; i < 2; ++i) { const float keep = b2 ? r4[i + 2] : r4[i], send = b2 ? r4[i] : r4[i + 2]; r2[i] = keep + __shfl_xor(send, 4); } \
        { const float keep = b1 ? r2[1] : r2[0], send = b1 ? r2[0] : r2[1]; r1 = keep + __shfl_xor(send, 2); } \
        r1 += __shfl_xor(r1, 1); out = r1 + brm; } while (0)
        P6_REDUCE(pa, val0); P6_REDUCE(pb, val1);
#undef P6_REDUCE
        float tv0[4], tv1[4]; int ti0[4], ti1[4];
#pragma unroll
        for (int k = 0; k < 4; ++k) { float bv0 = val0, bv1 = val1; int bi0 = emine, bi1 = emine;
#pragma unroll
            for (int o = 2; o < 64; o <<= 1) { const float ov0 = __shfl_xor(bv0, o), ov1 = __shfl_xor(bv1, o); const int oi0 = __shfl_xor(bi0, o), oi1 = __shfl_xor(bi1, o);
                if (ov0 > bv0 || (ov0 == bv0 && oi0 < bi0)) { bv0 = ov0; bi0 = oi0; } if (ov1 > bv1 || (ov1 == bv1 && oi1 < bi1)) { bv1 = ov1; bi1 = oi1; } }
            tv0[k] = bv0; ti0[k] = bi0; if (emine == bi0) val0 = -INFINITY; tv1[k] = bv1; ti1[k] = bi1; if (emine == bi1) val1 = -INFINITY; }
        if (lane < 8) { const bool second = lane >= 4; const int k = lane & 3, m = second ? m1 : m0;
            const float t0 = second ? tv1[0] : tv0[0], t1 = second ? tv1[1] : tv0[1], t2 = second ? tv1[2] : tv0[2], t3 = second ? tv1[3] : tv0[3];
            const int i0 = second ? ti1[0] : ti0[0], i1 = second ? ti1[1] : ti0[1], i2 = second ? ti1[2] : ti0[2], i3 = second ? ti1[3] : ti0[3];
            const float e1 = __expf(t1 - t0), e2 = __expf(t2 - t0), e3 = __expf(t3 - t0), rs = 1.0f / (1.0f + e1 + e2 + e3);
            const int ek = (k == 0) ? i0 : (k == 1) ? i1 : (k == 2) ? i2 : i3; const float wk = ((k == 0) ? 1.0f : (k == 1) ? e1 : (k == 2) ? e2 : e3) * rs;
            const unsigned lp = __hip_atomic_fetch_add(lcnt + ek, 1u, __ATOMIC_RELAXED, __HIP_MEMORY_SCOPE_WORKGROUP);
            ent[(wave * 8 + 2 * pr + (second ? 1 : 0)) * 4 + k] = ((unsigned)ek << 16) | lp; wslot[4 * m + k] = wk; }
    }
    __syncthreads();
    if (tid_ < 32) lbase[tid_] = __hip_atomic_fetch_add(cnt + tid_, lcnt[tid_], RLX_AGENT);
    __syncthreads();
    if (tid_ < 256) { const unsigned en = ent[tid_]; const int e = (int)(en >> 16), lp = (int)(en & 0xffffu), w = tid_ >> 5, ri = (tid_ >> 2) & 7, k = tid_ & 3;
        const int m = (F.vcu * NWAVES + w) + ri * NGW; list[(size_t)e * LIST_CAP + lbase[e] + lp] = 4 * m + k; }
    __syncthreads();
}
__device__ __forceinline__ int moe_tables(Frame& F) {
    LAS int* tab = (LAS int*)(F.lds + TAB_OFF);
    if (fresh_tid() == 0) { int ts = 0; for (int e = 0; e < NE; ++e) { const int c = (int)__hip_atomic_load(F.ctl + CW_CNT + e, RLX_AGENT); tab[e] = ts; tab[40 + e] = c; ts += (c + 255) >> 8; } tab[32] = ts; }
    __syncthreads();
    return tab[32];
}
__device__ __forceinline__ void p9_final(Frame& F) {
    const int tid_ = fresh_tid(), lane = tid_ & 63, wave = __builtin_amdgcn_readfirstlane(tid_ >> 6);
    const int gw = F.vcu * NWAVES + wave, NGW = F.G * NWAVES;
    f32x4 gv[4], bv[4];
#pragma unroll
    for (int c = 0; c < 2; ++c) { gv[2 * c] = *(const f32x4*)(F.in[I_LN2G] + 512 * c + 8 * lane); gv[2 * c + 1] = *(const f32x4*)(F.in[I_LN2G] + 512 * c + 8 * lane + 4);
        bv[2 * c] = *(const f32x4*)(F.in[I_LN2B] + 512 * c + 8 * lane); bv[2 * c + 1] = *(const f32x4*)(F.in[I_LN2B] + 512 * c + 8 * lane + 4); }
    const bf16* H1B = (const bf16*)(F.ws + WS_H1B); const bf16* YS = (const bf16*)(F.ws + WS_YS);
    float probe_delta = 0.f;
    if (PROBE_STAMP >= 0) { const unsigned t1 = __hip_atomic_load(F.ctl + CW_TS + PROBE_STAMP, RLX_AGENT), t0 = __hip_atomic_load(F.ctl + CW_TS + (PROBE_STAMP > 0 ? PROBE_STAMP - 1 : 15), RLX_AGENT); probe_delta = (float)(t1 - t0) * 1e-6f; }
    for (int m0 = gw; m0 < M; m0 += 2 * NGW) {
        f32x4 v[2][4]; u32x4 hh[2][2], yy[2][4][2];
#pragma unroll
        for (int r = 0; r < 2; ++r) { const size_t m = (size_t)m0 + (size_t)r * NGW;
#pragma unroll
            for (int c = 0; c < 2; ++c) { hh[r][c] = *(const u32x4*)(H1B + m * D + 512 * c + 8 * lane);
#pragma unroll
                for (int k = 0; k < 4; ++k) yy[r][k][c] = *(const u32x4*)(YS + (4 * m + k) * D + 512 * c + 8 * lane); } }
#pragma unroll
        for (int r = 0; r < 2; ++r) { float s = 0.f;
#pragma unroll
            for (int c = 0; c < 2; ++c) { f32x4 a0, a1; pg8::unpack8(hh[r][c], a0, a1); a0 = a0 * ALPHA; a1 = a1 * ALPHA;
#pragma unroll
                for (int k = 0; k < 4; ++k) { f32x4 y0, y1; pg8::unpack8(yy[r][k][c], y0, y1); a0 = a0 + y0; a1 = a1 + y1; }
                v[r][2 * c] = a0; v[r][2 * c + 1] = a1; s += (a0.x + a0.y) + (a0.z + a0.w) + (a1.x + a1.y) + (a1.z + a1.w); }
            const float mean = wave_sum(s) * (1.f / D); float s2 = 0.f;
#pragma unroll
            for (int q = 0; q < 4; ++q) { v[r][q] = v[r][q] - mean; s2 += (v[r][q].x * v[r][q].x + v[r][q].y * v[r][q].y) + (v[r][q].z * v[r][q].z + v[r][q].w * v[r][q].w); }
            const float rstd = 1.f / sqrtf(wave_sum(s2) * (1.f / D) + LN_EPS);
            float* op = F.out + ((size_t)m0 + (size_t)r * NGW) * D + 8 * lane;
#pragma unroll
            for (int c = 0; c < 2; ++c) { *(f32x4*)(op + 512 * c) = v[r][2 * c] * rstd * gv[2 * c] + bv[2 * c] + probe_delta; *(f32x4*)(op + 512 * c + 4) = v[r][2 * c + 1] * rstd * gv[2 * c + 1] + bv[2 * c + 1] + probe_delta; } }
    }
}

struct Args { const float* in[31]; float* out; unsigned char* ws; int ph_lo, ph_hi, li, pad; };
__global__ void __launch_bounds__(NWAVES * 64, 2) fwd_kernel(Args args) {
    extern __shared__ __attribute__((aligned(16))) unsigned char lds_raw[];
    Frame F;
    F.lds = (LAS unsigned char*)lds_raw; F.MISC = (volatile LAS unsigned*)(F.lds + MISC_OFF);
    F.G = gridDim.x; { const int bx = blockIdx.x; F.vcu = (F.G % 8 == 0) ? (bx % 8) * (F.G / 8) + bx / 8 : bx; }
    F.ws = args.ws; F.ctl = (unsigned*)(args.ws + WS_CTL); F.out = args.out;
#pragma unroll
    for (int i = 0; i < 31; ++i) F.in[i] = args.in[i];
    for (int u = threadIdx.x; u < (LDS_BYTES - LDSCTL_OFF) / 4; u += NWAVES * 64) ((LAS unsigned*)(F.lds + LDSCTL_OFF))[u] = 0u;
    __syncthreads();
    XcdBarrier bar; bar.bar = F.ctl + CW_BAR; bar.x = 0; bar.st = nullptr;
    if (MK_N_LAUNCHES == 1) bar = xcd_barrier_post(F.ctl + CW_BAR, F.MISC + 8);
    int bar_no = 0;
    if (PROBE_STAMP >= 0 && blockIdx.x == 0 && threadIdx.x == 0) __hip_atomic_store(F.ctl + CW_TS + 15, (unsigned)__builtin_amdgcn_s_memrealtime(), RLX_AGENT);
#define GRID_BAR() do { if (MK_N_LAUNCHES == 1) xcd_barrier(bar); if (PROBE_STAMP >= 0) { if (blockIdx.x == 0 && threadIdx.x == 0) __hip_atomic_store(F.ctl + CW_TS + bar_no, (unsigned)__builtin_amdgcn_s_memrealtime(), RLX_AGENT); ++bar_no; } } while (0)
    const int lo = args.ph_lo, hi = args.ph_hi;
#define IN(k) (lo <= (k) && (k) < hi)
#define BOTH(k) (IN(k) && IN((k) + 1))
    using namespace pg8;
    LAS unsigned char* ring = F.lds;

    if (IN(0)) REP(0) { p0_prologue(F); if (BOTH(0)) GRID_BAR(); }

    if (IN(1)) REP(1) {
        p1_fcumsum(F);
        DenseSched S; S.init(M, 4096, F.G, (int)blockIdx.x); S.A = (const char*)(F.ws + WS_XN); S.Bt = (const char*)(F.ws + WS_WIN); S.a_tstep = (size_t)BM * D * 2; S.b_tstep = (size_t)BM * D * 2;
        EpiInProj E{(bf16*)(F.ws + WS_Q), (bf16*)(F.ws + WS_K), (bf16*)(F.ws + WS_V), (bf16*)(F.ws + WS_U3), (bf16*)(F.ws + WS_GA), (bf16*)(F.ws + WS_GB)};
        gemm_phase<EpiInProj, DenseSched, true, false>(ring, D, D, D, S, E);
        if (BOTH(1)) GRID_BAR();
    }
    if (IN(2)) {
        static_assert(attn_body::ATTN_LDS_BYTES <= RING_BYTES, "attention LDS");
        const int vcu = F.vcu, s16 = vcu & 15, bh0 = vcu >> 4;
        for (int step = 0; step < 5; ++step) {
            int j = -1;
            if (step == 0) j = (vcu < 64) ? vcu : ((vcu & 1) ? 576 + 2 * (vcu - 64) + 1 : -1);
            else if (step == 1) j = 64 + s16 * 16 + bh0;
            else if (step == 2) j = (vcu >= 64) ? 576 + 2 * (vcu - 64) : -1;
            else if (step == 3) j = 64 + (31 - s16) * 16 + bh0;
            else j = (vcu >= 64 && !(vcu & 1)) ? 576 + 2 * (vcu - 64) + 1 : -1;
            if (j < 0) continue;
            if (j < 64) ssm_job(F, j >> 5, j & 31);
            else if (j < 64 + 512) { const int a = j - 64, qb = 31 - (a >> 4), bh = a & 15;
                unsigned char* w_ = F.ws; asm volatile("" : "+s"(w_));
                attn_body::attn_unit<8>(bh >> 3, bh & 7, qb, (const attn_body::bf16*)(w_ + WS_Q), (const attn_body::bf16*)(w_ + WS_K), (const attn_body::bf16*)(w_ + WS_V),
                    (const attn_body::bf16*)(w_ + WS_SMALL + SM_KMETA), (const attn_body::bf16*)(w_ + WS_SMALL + SM_VMETA), (const float*)(w_ + WS_F2X), (const float*)(w_ + WS_SMALL + SM_F2M),
                    (attn_body::bf16*)(w_ + WS_YA), (char*)lds_raw); }
            else { moe_convert_job(F, j - 576); __syncthreads(); }
        }
        if (BOTH(2)) GRID_BAR();
    }
    if (IN(3)) REP(3) {
        { DenseSched S; S.init(M, SW, F.G, (int)blockIdx.x); S.A = (const char*)(F.ws + WS_YB); S.Bt = (const char*)(F.ws + WS_WGLU); S.a_tstep = (size_t)BM * SW * 2; S.b_tstep = (size_t)BM * SW * 2;
          EpiGate<0> E{(bf16*)(F.ws + WS_YG), (const bf16*)(F.ws + WS_YB), nullptr, F.in[I_BGLU], SW};
          gemm_phase<EpiGate<0>, DenseSched, true, false>(ring, SW, SW, SW, S, E); }
        { DenseSched S; S.init(M, D, F.G, (int)blockIdx.x); S.A = (const char*)(F.ws + WS_YA); S.Bt = (const char*)(F.ws + WS_WUPA); S.a_tstep = (size_t)BM * AW * 2; S.b_tstep = (size_t)BM * AW * 2;
          EpiGate<1> E{(bf16*)(F.ws + WS_T1), nullptr, (const bf16*)(F.ws + WS_GA), nullptr, D};
          gemm_phase<EpiGate<1>, DenseSched, true, false>(ring, AW, AW, AW, S, E); }
        if (BOTH(3)) GRID_BAR();
    }
    if (IN(4)) REP(4) {
        DenseSched S; S.init(M, D, F.G, (int)blockIdx.x); S.A = (const char*)(F.ws + WS_YG); S.Bt = (const char*)(F.ws + WS_WUPB); S.a_tstep = (size_t)BM * SW * 2; S.b_tstep = (size_t)BM * SW * 2;
        EpiGate<2> E{(bf16*)(F.ws + WS_MG), (const bf16*)(F.ws + WS_T1), (const bf16*)(F.ws + WS_GB), nullptr, D};
        gemm_phase<EpiGate<2>, DenseSched, true, false>(ring, SW, SW, SW, S, E);
        if (BOTH(4)) GRID_BAR();
    }
    if (IN(5)) REP(5) {
        DenseSched S; S.init(M, D, F.G, (int)blockIdx.x); S.A = (const char*)(F.ws + WS_MG); S.Bt = (const char*)(F.ws + WS_WO); S.a_tstep = (size_t)BM * D * 2; S.b_tstep = (size_t)BM * D * 2;
        EpiMix E{(float*)(F.ws + WS_MIX), (const bf16*)(F.ws + WS_XN)};
        gemm_phase<EpiMix, DenseSched, true, false>(ring, D, D, D, S, E);
        if (BOTH(5)) GRID_BAR();
    }
    if (IN(6)) REP(6) { p6_ln1_router(F, rep_); if (BOTH(6)) GRID_BAR(); }

    if (IN(7)) REP(7) {
        const int ntile = moe_tables(F);
        MoeSched S; S.tab = (const LAS int*)(F.lds + TAB_OFF); S.G = F.G; S.c = (int)blockIdx.x; S.npn = 8; S.total = ntile * 8;
        S.A = (const char*)(F.ws + WS_H1B); S.a_tstep = 0; S.Bt = (const char*)(F.ws + WS_WGU); S.b_estep = (size_t)2048 * D * 2; S.b_tstep = (size_t)BM * D * 2; S.list = (const int*)(F.ws + WS_LIST);
        EpiMoe1 E{(bf16*)(F.ws + WS_ACT), F.in[I_BG], F.in[I_BU]};
        gemm_phase<EpiMoe1, MoeSched, true, true>(ring, D, D, D, S, E);
        if (BOTH(7)) GRID_BAR();
    }
    if (IN(8)) REP(8) {
        const int ntile = moe_tables(F);
        MoeSched S; S.tab = (const LAS int*)(F.lds + TAB_OFF); S.G = F.G; S.c = (int)blockIdx.x; S.npn = 4; S.total = ntile * 4;
        S.A = (const char*)(F.ws + WS_ACT); S.a_tstep = (size_t)BM * D * 2; S.Bt = (const char*)(F.ws + WS_WD); S.b_estep = (size_t)D * D * 2; S.b_tstep = (size_t)BM * D * 2; S.list = (const int*)(F.ws + WS_LIST);
        EpiMoe2 E{(bf16*)(F.ws + WS_YS), F.in[I_BD], (const int*)(F.ws + WS_LIST), (const float*)(F.ws + WS_WSLOT), (const LAS int*)(F.lds + TAB_OFF)};
        gemm_phase<EpiMoe2, MoeSched, true, false>(ring, D, D, D, S, E);
        if (BOTH(8)) GRID_BAR();
    }
    if (IN(9)) REP(9) { p9_final(F); if (PROBE_REPEAT == 9 && rep_ == 0) GRID_BAR(); }
#undef IN
#undef BOTH
#undef GRID_BAR
}

extern "C" void kernel_launch(void* const* d_in, const int* in_sizes, int n_in, void* d_out, int out_size, void* d_ws, size_t ws_size, hipStream_t stream) {
    static int grid = 0;
    if (grid == 0) {
        if (n_in != 31 || in_sizes[0] != M * D || out_size != M * D || ws_size < WS_END) { fprintf(stderr, "kernel_launch: unexpected shapes / workspace (n_in %d, ws %zu, need %zu)\n", n_in, ws_size, (size_t)WS_END); grid = -1; return; }
        int dev = 0, cus = 0, per_cu = 0;
        if (hipGetDevice(&dev) != hipSuccess || hipDeviceGetAttribute(&cus, hipDeviceAttributeMultiprocessorCount, dev) != hipSuccess) { grid = -1; return; }
        if (hipFuncSetAttribute((const void*)fwd_kernel, hipFuncAttributeMaxDynamicSharedMemorySize, LDS_BYTES) != hipSuccess) { fprintf(stderr, "kernel_launch: hipFuncSetAttribute failed\n"); grid = -1; return; }
        if (hipOccupancyMaxActiveBlocksPerMultiprocessor(&per_cu, (const void*)fwd_kernel, NWAVES * 64, LDS_BYTES) != hipSuccess || per_cu < 1) fprintf(stderr, "kernel_launch: occupancy query reports %d\n", per_cu);
        (void)hipGetLastError();
        grid = cus;
        if (grid != 256) { fprintf(stderr, "kernel_launch: built for a 256-CU device, got %d\n", grid); grid = -1; return; }
    }
    if (grid < 0) return;
    if (hipMemsetAsync((char*)d_ws + WS_CTL, 0, CTL_ZERO_BYTES, stream) != hipSuccess) return;
    Args a{};
    for (int i = 0; i < 31; ++i) a.in[i] = (const float*)d_in[i];
    a.out = (float*)d_out; a.ws = (unsigned char*)d_ws; a.pad = 0;
    if (MK_N_LAUNCHES == 1) { a.ph_lo = 0; a.ph_hi = NPHASES; a.li = 0; hipLaunchKernelGGL(fwd_kernel, dim3(grid), dim3(NWAVES * 64), LDS_BYTES, stream, a); }
    else { for (int li = 0; li < NPHASES; ++li) { a.ph_lo = li; a.ph_hi = li + 1; a.li = li; hipLaunchKernelGGL(fwd_kernel, dim3(grid), dim3(NWAVES * 64), LDS_BYTES, stream, a); } }
}
```
